# Optimizing an MI355X kernel written in HIP

```python
import jax, jax.numpy as jnp
from jax import lax
import numpy as np

D_MODEL = 1024
BATCH = 8
SEQ = 2048
DEPTH = 1
DEC_BATCH = 128
DEC_SEQ = 1
PAST_LEN = 16384
PAGE_SIZE = 128

D_CONV = D_MODEL
D_POOL = D_MODEL // 2
N_POOL_GROUPS = 4
POOL_GROUP = D_POOL // N_POOL_GROUPS
POOL_OUT_GROUP = D_MODEL // N_POOL_GROUPS
POOL_WINDOWS = (2, 4, 8, 16)
POOL_STATE = max(POOL_WINDOWS) - 1
CONV_WIDTH = 3
D_FF = ((8 * D_MODEL // 3 + 127) // 128) * 128
ALPHA = (2.0 * DEPTH) ** 0.25
BETA = (8.0 * DEPTH) ** -0.25
LN_EPS = 1e-5
SPLITS = [D_CONV, 2 * D_CONV, 3 * D_CONV, 3 * D_CONV + D_POOL, 3 * D_CONV + D_POOL + D_MODEL]
D_IN = 3 * D_CONV + D_POOL + 2 * D_MODEL

kernel_name = "gated_conv_pool_macaron_deepnorm_step"


def layer_norm(x, g, b):
    xf = x.astype(jnp.float32)
    mu = jnp.mean(xf, axis=-1, keepdims=True)
    var = jnp.mean(jnp.square(xf - mu), axis=-1, keepdims=True)
    y = (xf - mu) * lax.rsqrt(var + LN_EPS)
    return (y * g.astype(jnp.float32) + b.astype(jnp.float32)).astype(x.dtype)


def swiglu(x, wg, wu, wd):
    hid = jax.nn.silu(jnp.einsum('btd,df->btf', x, wg)) * jnp.einsum('btd,df->btf', x, wu)
    return jnp.einsum('btf,fd->btd', hid, wd)


def short_conv(u_ext, conv_w, t_new):
    out = conv_w[0] * u_ext[:, 0:t_new]
    for k in range(1, CONV_WIDTH):
        out = out + conv_w[k] * u_ext[:, k:k + t_new]
    return out


def multiscale_pool(p_ext, pos0, t_new):
    pf = p_ext.astype(jnp.float32)
    bsz = pf.shape[0]
    cs = jnp.concatenate([jnp.zeros((bsz, 1, D_POOL), jnp.float32), jnp.cumsum(pf, axis=1)], axis=1)
    pos = pos0 + jnp.arange(t_new)
    outs = []
    for g, w in enumerate(POOL_WINDOWS):
        sl = slice(g * POOL_GROUP, (g + 1) * POOL_GROUP)
        hi = cs[:, POOL_STATE + 1:POOL_STATE + 1 + t_new, sl]
        lo = cs[:, POOL_STATE + 1 - w:POOL_STATE + 1 - w + t_new, sl]
        cnt = jnp.minimum(pos + 1, w).astype(jnp.float32)[None, :, None]
        outs.append((hi - lo) / cnt)
    mean = jnp.concatenate(outs, axis=-1)
    return (mean - pf[:, POOL_STATE:]).astype(p_ext.dtype)


def hybrid_layer(x, conv_state, pool_state, pos0, ln1_g, ln1_b, ffn1_wg, ffn1_wu, ffn1_wd,
                 w_in, conv_w, pool_w, pool_scale, w_out, ln2_g, ln2_b,
                 ffn2_wg, ffn2_wu, ffn2_wd, ln3_g, ln3_b):
    bsz, t_new, _ = x.shape
    x = layer_norm(ALPHA * x + 0.5 * swiglu(x, ffn1_wg, ffn1_wu, ffn1_wd), ln1_g, ln1_b)
    z = jnp.einsum('btd,de->bte', x, w_in)
    c_g, b_g, h, p, g_a, g_p = jnp.split(z, SPLITS, axis=-1)
    u = c_g * h
    u_ext = jnp.concatenate([conv_state.astype(u.dtype), u], axis=1)
    y_a = b_g * short_conv(u_ext, conv_w, t_new)
    p_ext = jnp.concatenate([pool_state.astype(p.dtype), p], axis=1)
    q = multiscale_pool(p_ext, pos0, t_new)
    y_p = jnp.einsum('btgc,gce->btge', q.reshape(bsz, t_new, N_POOL_GROUPS, POOL_GROUP), pool_w)
    y_p = y_p.reshape(bsz, t_new, D_MODEL) * pool_scale
    m = jax.nn.sigmoid(g_a) * y_a + jax.nn.sigmoid(g_p) * y_p
    x = layer_norm(ALPHA * x + jnp.einsum('btd,de->bte', m, w_out), ln2_g, ln2_b)
    x = layer_norm(ALPHA * x + 0.5 * swiglu(x, ffn2_wg, ffn2_wu, ffn2_wd), ln3_g, ln3_b)
    return x, u_ext[:, -(CONV_WIDTH - 1):], p_ext[:, -POOL_STATE:]


def setup_inputs(seed: int = 0) -> dict:
    key = jax.random.key(seed)
    ks = jax.random.split(key, 24)
    f32 = jnp.float32
    nrm = lambda k, shape, s: jax.random.normal(k, shape, f32) * s
    L = DEPTH
    return {
        "x_prompt": nrm(ks[0], (BATCH, SEQ, D_MODEL), 1.0),
        "x_sample": nrm(ks[1], (DEC_BATCH, DEC_SEQ, D_MODEL), 1.0),
        "state_conv": nrm(ks[2], (L, DEC_BATCH, CONV_WIDTH - 1, D_CONV), 1.0),
        "state_pool": nrm(ks[3], (L, DEC_BATCH, POOL_STATE, D_POOL), 1.0),
        "ln1_g": 1.0 + nrm(ks[4], (L, D_MODEL), 0.02),
        "ln1_b": nrm(ks[5], (L, D_MODEL), 0.02),
        "ffn1_wg": nrm(ks[6], (L, D_MODEL, D_FF), D_MODEL ** -0.5),
        "ffn1_wu": nrm(ks[7], (L, D_MODEL, D_FF), D_MODEL ** -0.5),
        "ffn1_wd": nrm(ks[8], (L, D_FF, D_MODEL), BETA * D_FF ** -0.5),
        "w_in": nrm(ks[9], (L, D_MODEL, D_IN), D_MODEL ** -0.5),
        "conv_w": nrm(ks[10], (L, CONV_WIDTH, D_CONV), CONV_WIDTH ** -0.5),
        "pool_w": nrm(ks[11], (L, N_POOL_GROUPS, POOL_GROUP, POOL_OUT_GROUP), POOL_GROUP ** -0.5),
        "pool_scale": 1.0 + nrm(ks[12], (L, D_MODEL), 0.02),
        "w_out": nrm(ks[13], (L, D_MODEL, D_MODEL), BETA * D_MODEL ** -0.5),
        "ln2_g": 1.0 + nrm(ks[14], (L, D_MODEL), 0.02),
        "ln2_b": nrm(ks[15], (L, D_MODEL), 0.02),
        "ffn2_wg": nrm(ks[16], (L, D_MODEL, D_FF), D_MODEL ** -0.5),
        "ffn2_wu": nrm(ks[17], (L, D_MODEL, D_FF), D_MODEL ** -0.5),
        "ffn2_wd": nrm(ks[18], (L, D_FF, D_MODEL), BETA * D_FF ** -0.5),
        "ln3_g": 1.0 + nrm(ks[19], (L, D_MODEL), 0.02),
        "ln3_b": nrm(ks[20], (L, D_MODEL), 0.02),
    }


def reference(x_prompt, x_sample, state_conv, state_pool, ln1_g, ln1_b, ffn1_wg, ffn1_wu, ffn1_wd,
              w_in, conv_w, pool_w, pool_scale, w_out, ln2_g, ln2_b,
              ffn2_wg, ffn2_wu, ffn2_wd, ln3_g, ln3_b):
    bp = x_prompt.shape[0]
    yp, ys = x_prompt, x_sample
    conv_p, pool_p, conv_s, pool_s = [], [], [], []
    for l in range(DEPTH):
        w = (ln1_g[l], ln1_b[l], ffn1_wg[l], ffn1_wu[l], ffn1_wd[l], w_in[l], conv_w[l], pool_w[l],
             pool_scale[l], w_out[l], ln2_g[l], ln2_b[l], ffn2_wg[l], ffn2_wu[l], ffn2_wd[l],
             ln3_g[l], ln3_b[l])
        zc = jnp.zeros((bp, CONV_WIDTH - 1, D_CONV), yp.dtype)
        zp = jnp.zeros((bp, POOL_STATE, D_POOL), yp.dtype)
        yp, cp, pp = hybrid_layer(yp, zc, zp, 0, *w)
        ys, cs_, ps_ = hybrid_layer(ys, state_conv[l], state_pool[l], PAST_LEN, *w)
        conv_p.append(cp); pool_p.append(pp); conv_s.append(cs_); pool_s.append(ps_)
    return (yp, ys, jnp.stack(conv_p), jnp.stack(pool_p), jnp.stack(conv_s), jnp.stack(pool_s))
```

```cpp
#include <hip/hip_runtime.h>
#include <hip/hip_cooperative_groups.h>
#include <cstdio>
#include <cstdint>
namespace cg = cooperative_groups;

#define LAS __attribute__((address_space(3)))
typedef unsigned short bf16_t;
typedef short bf16x8 __attribute__((ext_vector_type(8)));
typedef float f32x4 __attribute__((ext_vector_type(4)));
typedef float f32x2 __attribute__((ext_vector_type(2)));
typedef unsigned u32x4 __attribute__((ext_vector_type(4)));
typedef unsigned u32x2 __attribute__((ext_vector_type(2)));

constexpr int D = 1024, FF = 2816, NGU = 2 * FF, NIN = 5632, DP = 512;
constexpr int SEQ = 2048, NB = 8, MPR = NB * SEQ, MS = 128, MT = MPR + MS, MPAD = 16640;
constexpr int ZLD = 3584;
constexpr float ALPHA = 1.18920711500272f;
constexpr float LN_EPS = 1e-5f;
constexpr size_t MiB = 1u << 20;
constexpr size_t WS_CTL = 0, WS_WGU1 = 1 * MiB, WS_WD1 = 12 * MiB, WS_WIN = 17 * MiB + 512 * 1024, WS_WOUT = 28 * MiB + 512 * 1024, WS_WGU2 = 30 * MiB + 512 * 1024,
                 WS_WD2 = 41 * MiB + 512 * 1024, WS_PW = 47 * MiB, WS_RA = 48 * MiB, WS_RC = 80 * MiB + 512 * 1024, WS_RB = 113 * MiB, WS_END = 227 * MiB;
static_assert(WS_RA + (size_t)MPAD * D * 2 <= WS_RC && WS_RC + (size_t)MPAD * D * 2 <= WS_RB && WS_RB + (size_t)MPAD * ZLD * 2 <= WS_END, "ws map");
constexpr size_t OUT_CONVP = (size_t)MT * D, OUT_POOLP = OUT_CONVP + (size_t)NB * 2 * D, OUT_CONVS = OUT_POOLP + (size_t)NB * 15 * DP, OUT_POOLS = OUT_CONVS + (size_t)MS * 2 * D,
                 OUT_END = OUT_POOLS + (size_t)MS * 15 * DP;
constexpr int LDS_BYTES = 147456;
constexpr int NPHASE = 11;

__device__ __forceinline__ unsigned cvt_pk_bf16(float lo, float hi) { unsigned r; asm volatile("v_cvt_pk_bf16_f32 %0, %1, %2" : "=v"(r) : "v"(lo), "v"(hi)); return r; }
__device__ __forceinline__ float bf_lo(unsigned w) { return __uint_as_float(w << 16); }
__device__ __forceinline__ float bf_hi(unsigned w) { return __uint_as_float(w & 0xffff0000u); }
__device__ __forceinline__ float sigmoidf_(float x) { return __builtin_amdgcn_rcpf(1.0f + __builtin_amdgcn_exp2f(x * -1.44269504088896f)); }
#define LDS_WAIT() asm volatile("s_waitcnt lgkmcnt(0)" ::: "memory")

namespace pg8 {
constexpr int BM = 256, BK = 64, HALF = 128, HTB = HALF * BK * 2, STAGE_BYTES = 8 * HTB, NXCD = 8, WGM = 8;
__host__ __device__ __forceinline__ int lds_byte(int r, int c) { const int st = (r >> 4) * 2 + (c >> 5), rr = r & 15, cc = c & 31, ob = rr * 64 + cc * 2; return st * 1024 + (ob ^ (((ob >> 9) & 1) << 5)); }
__host__ __device__ __forceinline__ void stage_rc(int b, int& R, int& C) { const int st = b / 1024, sb = b % 1024, swz = sb ^ (((sb >> 9) & 1) << 5); R = (st >> 1) * 16 + swz / 64; C = (st & 1) * 32 + (swz % 64) / 2; }
struct Unit { int pm, pn; };
struct Gemm { const bf16_t* A; const bf16_t* Bt; int M, N, K; };
struct StaticOrder {
    int nM, nN, nwg, G, c;
    __host__ __device__ void init(int M, int N, int G_, int c_) { nM = M / BM; nN = N / BM; nwg = nM * nN; G = G_; c = c_; }
    __host__ __device__ bool next(int i, Unit& u) const {
        const long L = (long)i * G + c; if (L >= nwg) return false;
        int wgid = (int)L; { const int q = nwg / NXCD, r = nwg % NXCD, xcd = wgid % NXCD, off = wgid / NXCD; wgid = (xcd < r ? xcd * (q + 1) : r * (q + 1) + (xcd - r) * q) + off; }
        const int nig = WGM * nN, gid = wgid / nig, fm = gid * WGM, gsz = (nM - fm) < WGM ? (nM - fm) : WGM;
        u.pm = fm + ((wgid % nig) % gsz); u.pn = (wgid % nig) / gsz; return true;
    }
};
template <class Epi, bool ALIGN_EPI, bool SP2>
__device__ __forceinline__ void gemm_phase(LAS unsigned char* lds, const Gemm g, const StaticOrder& S, const Epi& E) {
    const int tid = threadIdx.x, wid = __builtin_amdgcn_readfirstlane(tid >> 6), lane = tid & 63, wr = wid >> 2, wc = wid & 3, fr = lane & 15, fq = lane >> 4;
    const int K = g.K, nt = K / BK;
    unsigned voffA[2];
#pragma unroll
    for (int i = 0; i < 2; ++i) { int R, C; stage_rc(tid * 16 + i * 8192, R, C); voffA[i] = (unsigned)(R * K + C) * 2u; }
    const size_t kstep = (size_t)(BK * 2);
    const size_t hstep = (size_t)HALF * K * 2;
    const size_t tstep = 2 * hstep;
    const unsigned ldsw = (unsigned)wid * 1024u;
    const int aoff = lds_byte(wr * 64 + fr, fq * 8), boff = lds_byte(wc * 32 + fr, fq * 8);
#define PG8_SA(b, h) (((b) * 2 + (h)) * HTB)
#define PG8_SB(b, h) ((4 + (b) * 2 + (h)) * HTB)
#define PG8_STAGE(bufoff, gbase) do { _Pragma("unroll") for (int _i = 0; _i < 2; ++_i) \
        __builtin_amdgcn_global_load_lds((const unsigned*)((const char*)(gbase) + voffA[_i]), (LAS unsigned*)(lds + (bufoff) + ldsw + _i * 8192), 16, 0, 0); } while (0)
#define PG8_LDA(dst, b, h) do { _Pragma("unroll") for (int m = 0; m < 4; ++m) _Pragma("unroll") for (int k = 0; k < 2; ++k) dst[m][k] = *(const LAS bf16x8*)(lds + PG8_SA(b, h) + aoff + m * 2048 + k * 1024); } while (0)
#define PG8_LDB(dst, b, h) do { _Pragma("unroll") for (int n = 0; n < 2; ++n) _Pragma("unroll") for (int k = 0; k < 2; ++k) dst[n][k] = *(const LAS bf16x8*)(lds + PG8_SB(b, h) + boff + n * 2048 + k * 1024); } while (0)
#define PG8_MMA(ai, bj, At, Bt) do { __builtin_amdgcn_s_setprio(1); _Pragma("unroll") for (int m = 0; m < 4; ++m) _Pragma("unroll") for (int n = 0; n < 2; ++n) _Pragma("unroll") for (int k = 0; k < 2; ++k) \
        acc[ai][bj][m][n] = __builtin_amdgcn_mfma_f32_16x16x32_bf16(Bt[n][k], At[m][k], acc[ai][bj][m][n], 0, 0, 0); __builtin_amdgcn_s_setprio(0); } while (0)
#define PG8_WAIT_V(n) asm volatile("s_waitcnt vmcnt(" #n ")" ::: "memory")
#define PG8_WAIT_L(n) asm volatile("s_waitcnt lgkmcnt(" #n ")" ::: "memory")
#define PG8_BAR __builtin_amdgcn_s_barrier()
#define PG8_SCHED __builtin_amdgcn_sched_barrier(0)
    Unit cur, nxt; int ui = 0;
    if (!S.next(0, cur)) return;
    f32x4 acc[2][2][4][2];
#pragma unroll
    for (int a = 0; a < 2; ++a)
#pragma unroll
        for (int b = 0; b < 2; ++b)
#pragma unroll
            for (int m = 0; m < 4; ++m)
#pragma unroll
                for (int n = 0; n < 2; ++n) acc[a][b][m][n] = (f32x4){0.f, 0.f, 0.f, 0.f};
    bf16x8 At[4][2], B0[2][2], B1[2][2];
    const char* cA = (const char*)g.A + (size_t)cur.pm * tstep; const char* cB = (const char*)g.Bt + (size_t)cur.pn * tstep;
    if constexpr (SP2) {
        PG8_STAGE(PG8_SB(0, 0), cB); PG8_STAGE(PG8_SB(0, 1), cB + hstep); PG8_STAGE(PG8_SA(0, 0), cA); PG8_STAGE(PG8_SA(0, 1), cA + hstep);
        if (wr == 1) PG8_BAR;
        PG8_WAIT_V(2); PG8_BAR;
        PG8_STAGE(PG8_SB(1, 0), cB + kstep); PG8_STAGE(PG8_SA(1, 0), cA + kstep); PG8_STAGE(PG8_SB(1, 1), cB + hstep + kstep);
        PG8_WAIT_V(6); PG8_BAR;
    } else {
        PG8_STAGE(PG8_SB(0, 0), cB); PG8_STAGE(PG8_SA(0, 0), cA); PG8_STAGE(PG8_SB(0, 1), cB + hstep); PG8_STAGE(PG8_SA(0, 1), cA + hstep);
        if (wr == 1) PG8_BAR;
        PG8_WAIT_V(4); PG8_BAR;
        PG8_STAGE(PG8_SB(1, 0), cB + kstep); PG8_STAGE(PG8_SA(1, 0), cA + kstep); PG8_STAGE(PG8_SB(1, 1), cB + hstep + kstep);
        PG8_WAIT_V(6); PG8_BAR;
    }
    for (;;) {
        const bool has_next = S.next(ui + 1, nxt);
        const char* nA = has_next ? (const char*)g.A + (size_t)nxt.pm * tstep : cA; const char* nB = has_next ? (const char*)g.Bt + (size_t)nxt.pn * tstep : cB;
        for (int t = 0; t < nt; t += 2) {
            const bool last = (t == nt - 2);
            const char* a1 = cA + (size_t)(t + 1) * kstep;
            const char* a2 = last ? nA : cA + (size_t)(t + 2) * kstep; const char* b2 = last ? nB : cB + (size_t)(t + 2) * kstep;
            const char* a3 = a2 + kstep; const char* b3 = b2 + kstep;
            if constexpr (SP2) {
            PG8_LDB(B0, 0, 0); PG8_LDB(B1, 0, 1); PG8_SCHED; PG8_LDA(At, 0, 0); PG8_STAGE(PG8_SA(1, 1), a1 + hstep);
            PG8_WAIT_V(8); PG8_WAIT_L(0); PG8_BAR; PG8_MMA(0, 0, At, B0); PG8_MMA(0, 1, At, B1); PG8_BAR; PG8_SCHED;
            PG8_LDA(At, 0, 1); PG8_STAGE(PG8_SB(0, 0), b2); PG8_STAGE(PG8_SB(0, 1), b2 + hstep); PG8_STAGE(PG8_SA(0, 0), a2);
            PG8_WAIT_V(8); PG8_WAIT_L(0); PG8_BAR; PG8_MMA(1, 0, At, B0); PG8_MMA(1, 1, At, B1); PG8_BAR; PG8_SCHED;
            PG8_LDB(B0, 1, 0); PG8_LDB(B1, 1, 1); PG8_SCHED; PG8_LDA(At, 1, 0); PG8_STAGE(PG8_SA(0, 1), a2 + hstep);
            PG8_WAIT_V(8); PG8_WAIT_L(0); PG8_BAR; PG8_MMA(0, 0, At, B0); PG8_MMA(0, 1, At, B1); PG8_BAR; PG8_SCHED;
            PG8_LDA(At, 1, 1); PG8_STAGE(PG8_SB(1, 0), b3); PG8_STAGE(PG8_SB(1, 1), b3 + hstep); PG8_STAGE(PG8_SA(1, 0), a3);
            PG8_WAIT_V(8); PG8_WAIT_L(0); PG8_BAR; PG8_MMA(1, 0, At, B0); PG8_MMA(1, 1, At, B1); PG8_BAR; PG8_SCHED;
            } else {
            PG8_LDB(B0, 0, 0); PG8_SCHED; PG8_LDA(At, 0, 0); PG8_STAGE(PG8_SA(1, 1), a1 + hstep);
            PG8_WAIT_L(8); PG8_BAR; PG8_WAIT_L(0); PG8_MMA(0, 0, At, B0); PG8_BAR; PG8_SCHED;
            PG8_LDB(B1, 0, 1); PG8_STAGE(PG8_SB(0, 0), b2);
            PG8_BAR; PG8_WAIT_L(0); PG8_MMA(0, 1, At, B1); PG8_BAR;
            PG8_LDA(At, 0, 1); PG8_STAGE(PG8_SA(0, 0), a2);
            PG8_BAR; PG8_WAIT_L(0); PG8_MMA(1, 0, At, B0); PG8_BAR; PG8_SCHED;
            PG8_STAGE(PG8_SB(0, 1), b2 + hstep);
            PG8_WAIT_V(6); PG8_BAR; PG8_MMA(1, 1, At, B1); PG8_BAR;
            PG8_LDB(B0, 1, 0); PG8_SCHED; PG8_LDA(At, 1, 0); PG8_STAGE(PG8_SA(0, 1), a2 + hstep);
            PG8_WAIT_L(8); PG8_BAR; PG8_WAIT_L(0); PG8_MMA(0, 0, At, B0); PG8_BAR; PG8_SCHED;
            PG8_LDB(B1, 1, 1); PG8_STAGE(PG8_SB(1, 0), b3);
            PG8_BAR; PG8_WAIT_L(0); PG8_MMA(0, 1, At, B1); PG8_BAR;
            PG8_LDA(At, 1, 1); PG8_STAGE(PG8_SA(1, 0), a3);
            PG8_BAR; PG8_WAIT_L(0); PG8_MMA(1, 0, At, B0); PG8_BAR; PG8_SCHED;
            PG8_STAGE(PG8_SB(1, 1), b3 + hstep);
            PG8_WAIT_V(6); PG8_BAR; PG8_MMA(1, 1, At, B1); PG8_BAR;
            }
        }
        if constexpr (ALIGN_EPI) { if (wr == 0) PG8_BAR; }
        E(acc, cur, wr, wc, fr, fq);
        if (!has_next) break;
#pragma unroll
        for (int a = 0; a < 2; ++a)
#pragma unroll
            for (int b = 0; b < 2; ++b)
#pragma unroll
                for (int m = 0; m < 4; ++m)
#pragma unroll
                    for (int n = 0; n < 2; ++n) acc[a][b][m][n] = (f32x4){0.f, 0.f, 0.f, 0.f};
        cur = nxt; cA = nA; cB = nB; ++ui;
        if constexpr (ALIGN_EPI) { if (wr == 1) PG8_BAR; }
    }
    PG8_WAIT_V(0);
    if constexpr (!ALIGN_EPI) { if (wr == 0) PG8_BAR; }
    PG8_BAR;
#undef PG8_SA
#undef PG8_SB
#undef PG8_STAGE
#undef PG8_LDA
#undef PG8_LDB
#undef PG8_MMA
#undef PG8_WAIT_V
#undef PG8_WAIT_L
#undef PG8_BAR
#undef PG8_SCHED
}
}

__host__ __device__ __forceinline__ int pair_row(int ch, int w) { return 256 * (ch >> 7) + 128 * ((ch >> 2) & 1) + 32 * ((ch >> 5) & 3) + 16 * w + 4 * ((ch >> 3) & 3) + (ch & 3); }
__host__ __device__ __forceinline__ int plain8_row(int c) { return (c & ~255) + 128 * ((c >> 7) & 1) + 32 * ((c >> 5) & 3) + 16 * ((c >> 2) & 1) + 4 * ((c >> 3) & 3) + (c & 3); }
__device__ __forceinline__ int win_row(int n) {
    if (n < 1024) return pair_row(n, 0);
    if (n < 2048) return 2048 + pair_row(n - 1024, 0);
    if (n < 3072) return pair_row(n - 2048, 1);
    if (n < 3584) return 4096 + plain8_row(n - 3072);
    if (n < 4608) return 2048 + pair_row(n - 3584, 1);
    return 4608 + plain8_row(n - 4608);
}

struct EpiSwiGLU {
    bf16_t* H; int ldh;
    __device__ __forceinline__ void operator()(const f32x4 (&acc)[2][2][4][2], const pg8::Unit& u, int wr, int wc, int fr, int fq) const {
        const int row0 = u.pm * 256 + wr * 64 + fr, col0 = u.pn * 128 + wc * 32 + 8 * fq;
#pragma unroll
        for (int ai = 0; ai < 2; ++ai)
#pragma unroll
            for (int m = 0; m < 4; ++m) {
                bf16_t* rowp = H + (size_t)(row0 + ai * 128 + m * 16) * ldh + col0;
                float h[8];
#pragma unroll
                for (int bj = 0; bj < 2; ++bj)
#pragma unroll
                    for (int j = 0; j < 4; ++j) { const float g = acc[ai][bj][m][0][j], v = acc[ai][bj][m][1][j]; h[bj * 4 + j] = g * sigmoidf_(g) * v; }
                u32x4 w; w.x = cvt_pk_bf16(h[0], h[1]); w.y = cvt_pk_bf16(h[2], h[3]); w.z = cvt_pk_bf16(h[4], h[5]); w.w = cvt_pk_bf16(h[6], h[7]);
                *(u32x4*)rowp = w;
            }
    }
};
struct EpiZ {
    bf16_t* Z; const float* pool_scale;
    __device__ __forceinline__ void operator()(const f32x4 (&acc)[2][2][4][2], const pg8::Unit& u, int wr, int wc, int fr, int fq) const {
        const int row0 = u.pm * 256 + wr * 64 + fr;
        if (u.pn < 16) {
            const bool isu = u.pn < 8;
            const int col0 = (isu ? 128 * u.pn : 1024 + 128 * (u.pn - 8)) + wc * 32 + 8 * fq;
#pragma unroll
            for (int ai = 0; ai < 2; ++ai)
#pragma unroll
                for (int m = 0; m < 4; ++m) {
                    bf16_t* rowp = Z + (size_t)(row0 + ai * 128 + m * 16) * ZLD + col0;
                    float h[8];
#pragma unroll
                    for (int bj = 0; bj < 2; ++bj)
#pragma unroll
                        for (int j = 0; j < 4; ++j) { const float a = acc[ai][bj][m][0][j], b = acc[ai][bj][m][1][j]; h[bj * 4 + j] = isu ? a * b : a * sigmoidf_(b); }
                    u32x4 w; w.x = cvt_pk_bf16(h[0], h[1]); w.y = cvt_pk_bf16(h[2], h[3]); w.z = cvt_pk_bf16(h[4], h[5]); w.w = cvt_pk_bf16(h[6], h[7]);
                    *(u32x4*)rowp = w;
                }
        } else {
            const bool isp = u.pn < 18;
            const int cb = (isp ? 256 * (u.pn - 16) : 256 * (u.pn - 18)) + wc * 32 + 8 * fq;
            const int col0 = (isp ? 2048 : 2560) + cb;
            f32x4 ps[2][2];
#pragma unroll
            for (int bj = 0; bj < 2; ++bj)
#pragma unroll
                for (int n = 0; n < 2; ++n) ps[bj][n] = isp ? (f32x4){1.f, 1.f, 1.f, 1.f} : *(const f32x4*)(pool_scale + cb + 128 * bj + 4 * n);
#pragma unroll
            for (int ai = 0; ai < 2; ++ai)
#pragma unroll
                for (int m = 0; m < 4; ++m) {
                    bf16_t* rowp = Z + (size_t)(row0 + ai * 128 + m * 16) * ZLD + col0;
#pragma unroll
                    for (int bj = 0; bj < 2; ++bj) {
                        float h[8];
#pragma unroll
                        for (int n = 0; n < 2; ++n)
#pragma unroll
                            for (int j = 0; j < 4; ++j) { const float a = acc[ai][bj][m][n][j]; h[n * 4 + j] = isp ? a : sigmoidf_(a) * ps[bj][n][j]; }
                        u32x4 w; w.x = cvt_pk_bf16(h[0], h[1]); w.y = cvt_pk_bf16(h[2], h[3]); w.z = cvt_pk_bf16(h[4], h[5]); w.w = cvt_pk_bf16(h[6], h[7]);
                        *(u32x4*)(rowp + 128 * bj) = w;
                    }
                }
        }
    }
};
struct EpiRes {
    const float* base_p; const float* base_s; float* out; float scale;
    __device__ __forceinline__ void operator()(const f32x4 (&acc)[2][2][4][2], const pg8::Unit& u, int wr, int wc, int fr, int fq) const {
        const int row0 = u.pm * 256 + wr * 64 + fr, col0 = u.pn * 256 + wc * 32 + 4 * fq;
#pragma unroll
        for (int ai = 0; ai < 2; ++ai)
#pragma unroll
            for (int m = 0; m < 4; ++m) {
                const int row = row0 + ai * 128 + m * 16;
                if (row < MT) {
                    const float* bp = (row < MPR ? base_p + (size_t)row * D : base_s + (size_t)(row - MPR) * D) + col0;
                    float* op = out + (size_t)row * D + col0;
#pragma unroll
                    for (int bj = 0; bj < 2; ++bj)
#pragma unroll
                        for (int n = 0; n < 2; ++n) { const f32x4 b = *(const f32x4*)(bp + bj * 128 + n * 16); *(f32x4*)(op + bj * 128 + n * 16) = b * ALPHA + acc[ai][bj][m][n] * scale; }
                }
            }
    }
};

struct Args { const float* in[21]; float* out; unsigned char* ws; int ph_lo, ph_hi; };
enum { I_XP = 0, I_XS, I_SC, I_SP, I_LN1G, I_LN1B, I_WG1, I_WU1, I_WD1, I_WIN, I_CW, I_PW, I_PS, I_WOUT, I_LN2G, I_LN2B, I_WG2, I_WU2, I_WD2, I_LN3G, I_LN3B };

__device__ __forceinline__ float wave_sum(float v) {
#pragma unroll
    for (int o = 1; o < 64; o <<= 1) v += __shfl_xor(v, o);
    return v;
}
__device__ __forceinline__ void transpose_item(const float* W, int K, int N, bf16_t* WT, LAS float* scr, int item, int lane, int mode) {
    const int nblk = N / 32, kb = item / nblk, nb = item % nblk, k0 = 64 * kb, n0 = 32 * nb;
#pragma unroll 8
    for (int i = 0; i < 32; ++i) { const int kk = 2 * i + (lane >> 5); scr[kk * 33 + (lane & 31)] = W[(size_t)(k0 + kk) * N + n0 + (lane & 31)]; }
    LDS_WAIT(); asm volatile("" ::: "memory");
    const int c = lane & 7;
#pragma unroll
    for (int j = 0; j < 4; ++j) { const int n = (lane >> 3) + 8 * j; const LAS float* s = scr + (8 * c) * 33 + n;
        const int nn = n0 + n; const int r = mode == 0 ? nn : mode == 1 ? pair_row(nn, 0) : mode == 2 ? pair_row(nn, 1) : win_row(nn);
        u32x4 o; o.x = cvt_pk_bf16(s[0 * 33], s[1 * 33]); o.y = cvt_pk_bf16(s[2 * 33], s[3 * 33]); o.z = cvt_pk_bf16(s[4 * 33], s[5 * 33]); o.w = cvt_pk_bf16(s[6 * 33], s[7 * 33]);
        *(u32x4*)(WT + (size_t)r * K + k0 + 8 * c) = o; }
    LDS_WAIT(); asm volatile("" ::: "memory");
}

__device__ __forceinline__ void phase_prologue(const Args& a, LAS unsigned char* lds, int vcu, int G, int wave, int lane) {
    unsigned char* ws = a.ws;
    LAS float* scr = (LAS float*)(lds + wave * 16384);
    const int gw = vcu * 8 + wave, NGW = G * 8;
    constexpr int I_GU = (D / 64) * (FF / 32), I_DN = (FF / 64) * (D / 32), I_IN = (D / 64) * (NIN / 32), I_O = (D / 64) * (D / 32), I_P = (128 / 64) * (256 / 32);
    constexpr int NITEMS = 4 * I_GU + 2 * I_DN + I_IN + I_O + 4 * I_P;
    for (int it = gw; it < NITEMS; it += NGW) {
        int r = it;
        if (r < I_GU) { transpose_item(a.in[I_WG1], D, FF, (bf16_t*)(ws + WS_WGU1), scr, r, lane, 1); continue; } r -= I_GU;
        if (r < I_GU) { transpose_item(a.in[I_WU1], D, FF, (bf16_t*)(ws + WS_WGU1), scr, r, lane, 2); continue; } r -= I_GU;
        if (r < I_DN) { transpose_item(a.in[I_WD1], FF, D, (bf16_t*)(ws + WS_WD1), scr, r, lane, 0); continue; } r -= I_DN;
        if (r < I_IN) { transpose_item(a.in[I_WIN], D, NIN, (bf16_t*)(ws + WS_WIN), scr, r, lane, 3); continue; } r -= I_IN;
        if (r < I_O) { transpose_item(a.in[I_WOUT], D, D, (bf16_t*)(ws + WS_WOUT), scr, r, lane, 0); continue; } r -= I_O;
        if (r < I_GU) { transpose_item(a.in[I_WG2], D, FF, (bf16_t*)(ws + WS_WGU2), scr, r, lane, 1); continue; } r -= I_GU;
        if (r < I_GU) { transpose_item(a.in[I_WU2], D, FF, (bf16_t*)(ws + WS_WGU2), scr, r, lane, 2); continue; } r -= I_GU;
        if (r < I_DN) { transpose_item(a.in[I_WD2], FF, D, (bf16_t*)(ws + WS_WD2), scr, r, lane, 0); continue; } r -= I_DN;
        { const int g = r / I_P; transpose_item(a.in[I_PW] + (size_t)g * 128 * 256, 128, 256, (bf16_t*)(ws + WS_PW) + (size_t)g * 256 * 128, scr, r % I_P, lane, 0); }
    }
    const size_t gt = (size_t)vcu * 512 + threadIdx.x, NT = (size_t)G * 512;
    constexpr size_t NCH = (size_t)MT * D / 8, NCHP = (size_t)MPAD * D / 8, NPR = (size_t)MPR * D / 8;
    u32x4* ra = (u32x4*)(ws + WS_RA); u32x4* rc = (u32x4*)(ws + WS_RC);
    for (size_t c = gt; c < NCHP; c += NT) {
        if (c < NCH) {
            const float* src = c < NPR ? a.in[I_XP] + c * 8 : a.in[I_XS] + (c - NPR) * 8;
            const f32x4 v0 = *(const f32x4*)src, v1 = *(const f32x4*)(src + 4);
            u32x4 o; o.x = cvt_pk_bf16(v0[0], v0[1]); o.y = cvt_pk_bf16(v0[2], v0[3]); o.z = cvt_pk_bf16(v1[0], v1[1]); o.w = cvt_pk_bf16(v1[2], v1[3]);
            ra[c] = o;
        } else { ra[c] = (u32x4){0u, 0u, 0u, 0u}; rc[c] = (u32x4){0u, 0u, 0u, 0u}; }
    }
}

__device__ __forceinline__ void phase_ln(float* y, const float* gam, const float* bet, bf16_t* xb, int vcu, int G, int wave, int lane) {
    const int gw = vcu * 8 + wave, NGW = G * 8;
    f32x4 gv[4], bv[4];
#pragma unroll
    for (int j = 0; j < 4; ++j) { gv[j] = *(const f32x4*)(gam + 4 * lane + 256 * j); bv[j] = *(const f32x4*)(bet + 4 * lane + 256 * j); }
    for (int row = gw; row < MT; row += NGW) {
        f32x4* yr = (f32x4*)(y + (size_t)row * D) + lane;
        f32x4 v[4]; float s = 0.f;
#pragma unroll
        for (int j = 0; j < 4; ++j) { v[j] = yr[64 * j]; s += (v[j][0] + v[j][1]) + (v[j][2] + v[j][3]); }
        const float mean = wave_sum(s) * (1.f / D); float s2 = 0.f;
#pragma unroll
        for (int j = 0; j < 4; ++j) { v[j] = v[j] - mean; s2 += (v[j][0] * v[j][0] + v[j][1] * v[j][1]) + (v[j][2] * v[j][2] + v[j][3] * v[j][3]); }
        const float rstd = 1.f / sqrtf(wave_sum(s2) * (1.f / D) + LN_EPS);
#pragma unroll
        for (int j = 0; j < 4; ++j) { v[j] = v[j] * rstd * gv[j] + bv[j]; yr[64 * j] = v[j]; }
        if (xb) { u32x2* o8 = (u32x2*)(xb + (size_t)row * D) + lane;
#pragma unroll
            for (int j = 0; j < 4; ++j) { u32x2 w; w.x = cvt_pk_bf16(v[j][0], v[j][1]); w.y = cvt_pk_bf16(v[j][2], v[j][3]); o8[64 * j] = w; } }
    }
}

__device__ __forceinline__ void phase_mix(const Args& a, LAS unsigned char* lds, int vcu, int G, int wave, int lane) {
    const bf16_t* Z = (const bf16_t*)(a.ws + WS_RB); bf16_t* Mo = (bf16_t*)(a.ws + WS_RA); const bf16_t* PWT = (const bf16_t*)(a.ws + WS_PW);
    const float* sconv = a.in[I_SC]; const float* spool = a.in[I_SP]; const float* cw = a.in[I_CW];
    constexpr int PLD = 136;
    LAS bf16_t* Ps = (LAS bf16_t*)lds;
    LAS bf16_t* Qs = (LAS bf16_t*)(lds + 80 * PLD * 2);
    const int tid = threadIdx.x, fr = lane & 15, fq = lane >> 4;
    for (int item = vcu; item < (MT / 64) * 4; item += G) {
        const int rt = item >> 2, g = item & 3, r0 = rt * 64, w = 2 << g;
        const bool smp = r0 >= MPR; const int t0 = r0 & (SEQ - 1);
        for (int idx = tid; idx < 80 * 16; idx += 512) {
            const int i = idx >> 4, ck = idx & 15; u32x4 v = (u32x4){0u, 0u, 0u, 0u};
            const bool valid = smp ? (i >= 16) : (t0 - 16 + i >= 0);
            if (valid) v = *(const u32x4*)(Z + (size_t)(r0 - 16 + i) * ZLD + 2048 + 128 * g + 8 * ck);
            *(LAS u32x4*)(Ps + i * PLD + 8 * ck) = v;
        }
        __syncthreads();
        for (int idx = tid; idx < 64 * 16; idx += 512) {
            const int i = idx >> 4, ck = idx & 15;
            float s[8], pc[8];
            { const u32x4 v = *(const LAS u32x4*)(Ps + (16 + i) * PLD + 8 * ck);
              pc[0] = bf_lo(v.x); pc[1] = bf_hi(v.x); pc[2] = bf_lo(v.y); pc[3] = bf_hi(v.y); pc[4] = bf_lo(v.z); pc[5] = bf_hi(v.z); pc[6] = bf_lo(v.w); pc[7] = bf_hi(v.w); }
#pragma unroll
            for (int e = 0; e < 8; ++e) s[e] = pc[e];
            float inv;
            if (!smp) {
                for (int j = 1; j < w; ++j) { const u32x4 v = *(const LAS u32x4*)(Ps + (16 + i - j) * PLD + 8 * ck);
                    s[0] += bf_lo(v.x); s[1] += bf_hi(v.x); s[2] += bf_lo(v.y); s[3] += bf_hi(v.y); s[4] += bf_lo(v.z); s[5] += bf_hi(v.z); s[6] += bf_lo(v.w); s[7] += bf_hi(v.w); }
                const int cnt = (t0 + i + 1) < w ? (t0 + i + 1) : w; inv = 1.0f / (float)cnt;
            } else {
                const float* sp = spool + (size_t)(r0 - MPR + i) * 15 * DP + 128 * g + 8 * ck;
                for (int j = 1; j < w; ++j) { const f32x4 v0 = *(const f32x4*)(sp + (size_t)(15 - j) * DP), v1 = *(const f32x4*)(sp + (size_t)(15 - j) * DP + 4);
                    s[0] += v0[0]; s[1] += v0[1]; s[2] += v0[2]; s[3] += v0[3]; s[4] += v1[0]; s[5] += v1[1]; s[6] += v1[2]; s[7] += v1[3]; }
                inv = 1.0f / (float)w;
            }
#pragma unroll
            for (int e = 0; e < 8; ++e) s[e] = s[e] * inv - pc[e];
            u32x4 o; o.x = cvt_pk_bf16(s[0], s[1]); o.y = cvt_pk_bf16(s[2], s[3]); o.z = cvt_pk_bf16(s[4], s[5]); o.w = cvt_pk_bf16(s[6], s[7]);
            *(LAS u32x4*)(Qs + i * PLD + 8 * ck) = o;
        }
        __syncthreads();
        f32x4 acc[4][2];
#pragma unroll
        for (int mt = 0; mt < 4; ++mt)
#pragma unroll
            for (int nt = 0; nt < 2; ++nt) acc[mt][nt] = (f32x4){0.f, 0.f, 0.f, 0.f};
        const bf16_t* wbase = PWT + (size_t)g * 256 * 128 + (size_t)(wave * 32 + fr) * 128 + fq * 8;
#pragma unroll
        for (int ks = 0; ks < 4; ++ks) {
            bf16x8 wf[2], qf[4];
#pragma unroll
            for (int nt = 0; nt < 2; ++nt) wf[nt] = *(const bf16x8*)(wbase + (size_t)nt * 16 * 128 + ks * 32);
#pragma unroll
            for (int mt = 0; mt < 4; ++mt) qf[mt] = *(const LAS bf16x8*)(Qs + (mt * 16 + fr) * PLD + ks * 32 + fq * 8);
#pragma unroll
            for (int mt = 0; mt < 4; ++mt)
#pragma unroll
                for (int nt = 0; nt < 2; ++nt) acc[mt][nt] = __builtin_amdgcn_mfma_f32_16x16x32_bf16(wf[nt], qf[mt], acc[mt][nt], 0, 0, 0);
        }
#pragma unroll
        for (int nt = 0; nt < 2; ++nt) {
            const int e = 256 * g + wave * 32 + nt * 16 + 4 * fq;
            const f32x4 c0 = *(const f32x4*)(cw + e), c1 = *(const f32x4*)(cw + D + e), c2 = *(const f32x4*)(cw + 2 * D + e);
#pragma unroll
            for (int mt = 0; mt < 4; ++mt) {
                const int row = r0 + mt * 16 + fr; const bf16_t* zr = Z + (size_t)row * ZLD;
                const u32x2 uc = *(const u32x2*)(zr + e), bg = *(const u32x2*)(zr + 1024 + e), sg = *(const u32x2*)(zr + 2560 + e);
                f32x4 u0 = (f32x4){bf_lo(uc.x), bf_hi(uc.x), bf_lo(uc.y), bf_hi(uc.y)}, u1, u2;
                if (smp) { const float* sc = sconv + (size_t)(row - MPR) * 2 * D + e; u2 = *(const f32x4*)sc; u1 = *(const f32x4*)(sc + D); }
                else {
                    const int t = row & (SEQ - 1);
                    u1 = (f32x4){0.f, 0.f, 0.f, 0.f}; u2 = u1;
                    if (t >= 1) { const u32x2 x = *(const u32x2*)(zr - ZLD + e); u1 = (f32x4){bf_lo(x.x), bf_hi(x.x), bf_lo(x.y), bf_hi(x.y)}; }
                    if (t >= 2) { const u32x2 x = *(const u32x2*)(zr - 2 * ZLD + e); u2 = (f32x4){bf_lo(x.x), bf_hi(x.x), bf_lo(x.y), bf_hi(x.y)}; }
                }
                const f32x4 conv = c0 * u2 + c1 * u1 + c2 * u0;
                const f32x4 bgf = (f32x4){bf_lo(bg.x), bf_hi(bg.x), bf_lo(bg.y), bf_hi(bg.y)}, sgf = (f32x4){bf_lo(sg.x), bf_hi(sg.x), bf_lo(sg.y), bf_hi(sg.y)};
                const f32x4 mv = bgf * conv + sgf * acc[mt][nt];
                u32x2 o; o.x = cvt_pk_bf16(mv[0], mv[1]); o.y = cvt_pk_bf16(mv[2], mv[3]);
                *(u32x2*)(Mo + (size_t)row * D + e) = o;
            }
        }
        __syncthreads();
    }
    float* out = a.out;
    const size_t gt = (size_t)vcu * 512 + tid, NT = (size_t)G * 512;
    for (size_t i = gt; i < OUT_END - OUT_CONVP; i += NT) {
        const size_t o = OUT_CONVP + i; float v;
        if (o < OUT_POOLP) { const int b = (int)(i / (2 * D)), k = (int)(i / D) & 1, ch = (int)(i % D); v = __uint_as_float((unsigned)Z[(size_t)(b * SEQ + SEQ - 2 + k) * ZLD + ch] << 16); }
        else if (o < OUT_CONVS) { const size_t q = o - OUT_POOLP; const int b = (int)(q / (15 * DP)), r = (int)(q / DP) % 15, c = (int)(q % DP); v = __uint_as_float((unsigned)Z[(size_t)(b * SEQ + SEQ - 15 + r) * ZLD + 2048 + c] << 16); }
        else if (o < OUT_POOLS) { const size_t q = o - OUT_CONVS; const int b = (int)(q / (2 * D)), k = (int)(q / D) & 1, ch = (int)(q % D);
            v = k == 0 ? sconv[(size_t)b * 2 * D + D + ch] : __uint_as_float((unsigned)Z[(size_t)(MPR + b) * ZLD + ch] << 16); }
        else { const size_t q = o - OUT_POOLS; const int b = (int)(q / (15 * DP)), r = (int)(q / DP) % 15, c = (int)(q % DP);
            v = r < 14 ? spool[(size_t)b * 15 * DP + (size_t)(r + 1) * DP + c] : __uint_as_float((unsigned)Z[(size_t)(MPR + b) * ZLD + 2048 + c] << 16); }
        out[o] = v;
    }
}

__global__ void __launch_bounds__(512, 2) fwd_kernel(Args args) {
    extern __shared__ __attribute__((aligned(16))) unsigned char lds_raw[];
    LAS unsigned char* lds = (LAS unsigned char*)lds_raw;
    const int tid = threadIdx.x, lane = tid & 63, wave = __builtin_amdgcn_readfirstlane(tid >> 6);
    const int G = gridDim.x; const int bx = blockIdx.x; const int vcu = (G % 8 == 0) ? (bx % 8) * (G / 8) + bx / 8 : bx;
    const int lo = args.ph_lo, hi = args.ph_hi;
    unsigned char* ws = args.ws;
#define IN(k) (lo <= (k) && (k) < hi)
#define SEAM(k) do { if (IN(k) && IN((k) + 1)) { cg::this_grid().sync(); } } while (0)
    if (IN(0)) { phase_prologue(args, lds, vcu, G, wave, lane); }
    SEAM(0);
    if (IN(1)) { pg8::Gemm g{(const bf16_t*)(ws + WS_RA), (const bf16_t*)(ws + WS_WGU1), MPAD, NGU, D}; pg8::StaticOrder S; S.init(MPAD, NGU, G, bx);
        EpiSwiGLU E{(bf16_t*)(ws + WS_RB), FF}; pg8::gemm_phase<EpiSwiGLU, true, true>(lds, g, S, E); }
    SEAM(1);
    if (IN(2)) { pg8::Gemm g{(const bf16_t*)(ws + WS_RB), (const bf16_t*)(ws + WS_WD1), MPAD, D, FF}; pg8::StaticOrder S; S.init(MPAD, D, G, bx);
        EpiRes E{args.in[I_XP], args.in[I_XS], args.out, 0.5f}; pg8::gemm_phase<EpiRes, true, true>(lds, g, S, E); }
    SEAM(2);
    if (IN(3)) { phase_ln(args.out, args.in[I_LN1G], args.in[I_LN1B], (bf16_t*)(ws + WS_RC), vcu, G, wave, lane); }
    SEAM(3);
    if (IN(4)) { pg8::Gemm g{(const bf16_t*)(ws + WS_RC), (const bf16_t*)(ws + WS_WIN), MPAD, NIN, D}; pg8::StaticOrder S; S.init(MPAD, NIN, G, bx);
        EpiZ E{(bf16_t*)(ws + WS_RB), args.in[I_PS]}; pg8::gemm_phase<EpiZ, true, true>(lds, g, S, E); }
    SEAM(4);
    if (IN(5)) { phase_mix(args, lds, vcu, G, wave, lane); }
    SEAM(5);
    if (IN(6)) { pg8::Gemm g{(const bf16_t*)(ws + WS_RA), (const bf16_t*)(ws + WS_WOUT), MPAD, D, D}; pg8::StaticOrder S; S.init(MPAD, D, G, bx);
        EpiRes E{args.out, args.out + (size_t)MPR * D, args.out, 1.0f}; pg8::gemm_phase<EpiRes, true, true>(lds, g, S, E); }
    SEAM(6);
    if (IN(7)) { phase_ln(args.out, args.in[I_LN2G], args.in[I_LN2B], (bf16_t*)(ws + WS_RC), vcu, G, wave, lane); }
    SEAM(7);
    if (IN(8)) { pg8::Gemm g{(const bf16_t*)(ws + WS_RC), (const bf16_t*)(ws + WS_WGU2), MPAD, NGU, D}; pg8::StaticOrder S; S.init(MPAD, NGU, G, bx);
        EpiSwiGLU E{(bf16_t*)(ws + WS_RB), FF}; pg8::gemm_phase<EpiSwiGLU, true, true>(lds, g, S, E); }
    SEAM(8);
    if (IN(9)) { pg8::Gemm g{(const bf16_t*)(ws + WS_RB), (const bf16_t*)(ws + WS_WD2), MPAD, D, FF}; pg8::StaticOrder S; S.init(MPAD, D, G, bx);
        EpiRes E{args.out, args.out + (size_t)MPR * D, args.out, 0.5f}; pg8::gemm_phase<EpiRes, true, true>(lds, g, S, E); }
    SEAM(9);
    if (IN(10)) { phase_ln(args.out, args.in[I_LN3G], args.in[I_LN3B], nullptr, vcu, G, wave, lane); }
#undef IN
#undef SEAM
}

#ifndef N_LAUNCHES
#define N_LAUNCHES 1
#endif

extern "C" void kernel_launch(void* const* d_in, const int* in_sizes, int n_in, void* d_out, int out_size, void* d_ws, size_t ws_size, hipStream_t stream) {
    static int grid = 0;
    if (grid == 0) {
        if (n_in != 21 || in_sizes[0] != MPR * D || (size_t)out_size != OUT_END || ws_size < WS_END) {
            fprintf(stderr, "kernel_launch: unexpected shapes: n_in %d in0 %d out %d ws %zu\n", n_in, n_in > 0 ? in_sizes[0] : -1, out_size, ws_size); grid = -1; return; }
        int dev = 0, cus = 0, per_cu = 0;
        hipGetDevice(&dev); hipDeviceGetAttribute(&cus, hipDeviceAttributeMultiprocessorCount, dev);
        if (hipFuncSetAttribute((const void*)fwd_kernel, hipFuncAttributeMaxDynamicSharedMemorySize, LDS_BYTES) != hipSuccess) { fprintf(stderr, "kernel_launch: hipFuncSetAttribute failed\n"); grid = -1; return; }
        if (hipOccupancyMaxActiveBlocksPerMultiprocessor(&per_cu, (const void*)fwd_kernel, 512, LDS_BYTES) != hipSuccess || per_cu < 1) { fprintf(stderr, "kernel_launch: occupancy query says %d\n", per_cu); (void)hipGetLastError(); grid = -1; return; }
        grid = cus;
    }
    if (grid < 0) return;
    Args a{};
    for (int i = 0; i < 21; ++i) a.in[i] = (const float*)d_in[i];
    a.out = (float*)d_out; a.ws = (unsigned char*)d_ws;
    if (N_LAUNCHES == 1) {
        a.ph_lo = 0; a.ph_hi = NPHASE;
        void* params[] = {&a};
        hipError_t e = hipLaunchCooperativeKernel((const void*)fwd_kernel, dim3(grid), dim3(512), params, LDS_BYTES, stream);
        if (e != hipSuccess) fprintf(stderr, "cooperative launch failed: %s (grid %d)\n", hipGetErrorString(e), grid);
    } else {
        for (int p = 0; p < NPHASE; ++p) { a.ph_lo = p; a.ph_hi = p + 1; hipLaunchKernelGGL(fwd_kernel, dim3(grid), dim3(512), LDS_BYTES, stream, a); }
    }
}
```

```cpp
#include <hip/hip_runtime.h>
#include <hip/hip_cooperative_groups.h>
#include <cstdio>
#include <cstdint>
namespace cg = cooperative_groups;

#define LAS __attribute__((address_space(3)))
typedef unsigned short bf16_t;
typedef short bf16x8 __attribute__((ext_vector_type(8)));
typedef float f32x4 __attribute__((ext_vector_type(4)));
typedef float f32x2 __attribute__((ext_vector_type(2)));
typedef unsigned u32x4 __attribute__((ext_vector_type(4)));
typedef unsigned u32x2 __attribute__((ext_vector_type(2)));

constexpr int D = 1024, FF = 2816, NGU = 2 * FF, NIN = 5632, DP = 512;
constexpr int SEQ = 2048, NB = 8, MPR = NB * SEQ, MS = 128, MT = MPR + MS, MPAD = 16640;
constexpr int ZLD = 3584;
constexpr float ALPHA = 1.18920711500272f;
constexpr float LN_EPS = 1e-5f;
constexpr size_t MiB = 1u << 20;
constexpr size_t WS_CTL = 0, WS_WGU1 = 1 * MiB, WS_WD1 = 12 * MiB, WS_WIN = 17 * MiB + 512 * 1024, WS_WOUT = 28 * MiB + 512 * 1024, WS_WGU2 = 30 * MiB + 512 * 1024,
                 WS_WD2 = 41 * MiB + 512 * 1024, WS_PW = 47 * MiB, WS_RA = 48 * MiB, WS_RC = 80 * MiB + 512 * 1024, WS_RB = 113 * MiB, WS_END = 227 * MiB;
static_assert(WS_RA + (size_t)MPAD * D * 2 <= WS_RC && WS_RC + (size_t)MPAD * D * 2 <= WS_RB && WS_RB + (size_t)MPAD * ZLD * 2 <= WS_END, "ws map");
constexpr size_t OUT_CONVP = (size_t)MT * D, OUT_POOLP = OUT_CONVP + (size_t)NB * 2 * D, OUT_CONVS = OUT_POOLP + (size_t)NB * 15 * DP, OUT_POOLS = OUT_CONVS + (size_t)MS * 2 * D,
                 OUT_END = OUT_POOLS + (size_t)MS * 15 * DP;
constexpr int LDS_BYTES = 147456;
constexpr int NPHASE = 11;
#ifndef CG_SEAM
#define CG_SEAM 0
#endif
constexpr size_t CTL_ZERO_BYTES = 256 * 1024;

__device__ __forceinline__ unsigned cvt_pk_bf16(float lo, float hi) { unsigned r; asm volatile("v_cvt_pk_bf16_f32 %0, %1, %2" : "=v"(r) : "v"(lo), "v"(hi)); return r; }
__device__ __forceinline__ float bf_lo(unsigned w) { return __uint_as_float(w << 16); }
__device__ __forceinline__ float bf_hi(unsigned w) { return __uint_as_float(w & 0xffff0000u); }
__device__ __forceinline__ float sigmoidf_(float x) { return __builtin_amdgcn_rcpf(1.0f + __builtin_amdgcn_exp2f(x * -1.44269504088896f)); }
#define LDS_WAIT() asm volatile("s_waitcnt lgkmcnt(0)" ::: "memory")

namespace pg8 {
constexpr int BM = 256, BK = 64, HALF = 128, HTB = HALF * BK * 2, STAGE_BYTES = 8 * HTB, NXCD = 8, WGM = 8;
__host__ __device__ __forceinline__ int lds_byte(int r, int c) { const int st = (r >> 4) * 2 + (c >> 5), rr = r & 15, cc = c & 31, ob = rr * 64 + cc * 2; return st * 1024 + (ob ^ (((ob >> 9) & 1) << 5)); }
__host__ __device__ __forceinline__ void stage_rc(int b, int& R, int& C) { const int st = b / 1024, sb = b % 1024, swz = sb ^ (((sb >> 9) & 1) << 5); R = (st >> 1) * 16 + swz / 64; C = (st & 1) * 32 + (swz % 64) / 2; }
struct Unit { int pm, pn; };
struct Gemm { const bf16_t* A; const bf16_t* Bt; int M, N, K; };
struct StaticOrder {
    int nM, nN, nwg, G, c;
    __host__ __device__ void init(int M, int N, int G_, int c_) { nM = M / BM; nN = N / BM; nwg = nM * nN; G = G_; c = c_; }
    __host__ __device__ bool next(int i, Unit& u) const {
        const long L = (long)i * G + c; if (L >= nwg) return false;
        int wgid = (int)L; { const int q = nwg / NXCD, r = nwg % NXCD, xcd = wgid % NXCD, off = wgid / NXCD; wgid = (xcd < r ? xcd * (q + 1) : r * (q + 1) + (xcd - r) * q) + off; }
        const int nig = WGM * nN, gid = wgid / nig, fm = gid * WGM, gsz = (nM - fm) < WGM ? (nM - fm) : WGM;
        u.pm = fm + ((wgid % nig) % gsz); u.pn = (wgid % nig) / gsz; return true;
    }
};
template <class Epi, bool ALIGN_EPI, bool SP2>
__device__ __forceinline__ void gemm_phase(LAS unsigned char* lds, const Gemm g, const StaticOrder& S, const Epi& E) {
    const int tid = threadIdx.x, wid = __builtin_amdgcn_readfirstlane(tid >> 6), lane = tid & 63, wr = wid >> 2, wc = wid & 3, fr = lane & 15, fq = lane >> 4;
    const int K = g.K, nt = K / BK;
    unsigned voffA[2];
#pragma unroll
    for (int i = 0; i < 2; ++i) { int R, C; stage_rc(tid * 16 + i * 8192, R, C); voffA[i] = (unsigned)(R * K + C) * 2u; }
    const size_t kstep = (size_t)(BK * 2);
    const size_t hstep = (size_t)HALF * K * 2;
    const size_t tstep = 2 * hstep;
    const unsigned ldsw = (unsigned)wid * 1024u;
    const int aoff = lds_byte(wr * 64 + fr, fq * 8), boff = lds_byte(wc * 32 + fr, fq * 8);
#define PG8_SA(b, h) (((b) * 2 + (h)) * HTB)
#define PG8_SB(b, h) ((4 + (b) * 2 + (h)) * HTB)
#define PG8_STAGE(bufoff, gbase) do { _Pragma("unroll") for (int _i = 0; _i < 2; ++_i) \
        __builtin_amdgcn_global_load_lds((const unsigned*)((const char*)(gbase) + voffA[_i]), (LAS unsigned*)(lds + (bufoff) + ldsw + _i * 8192), 16, 0, 0); } while (0)
#define PG8_LDA(dst, b, h) do { _Pragma("unroll") for (int m = 0; m < 4; ++m) _Pragma("unroll") for (int k = 0; k < 2; ++k) dst[m][k] = *(const LAS bf16x8*)(lds + PG8_SA(b, h) + aoff + m * 2048 + k * 1024); } while (0)
#define PG8_LDB(dst, b, h) do { _Pragma("unroll") for (int n = 0; n < 2; ++n) _Pragma("unroll") for (int k = 0; k < 2; ++k) dst[n][k] = *(const LAS bf16x8*)(lds + PG8_SB(b, h) + boff + n * 2048 + k * 1024); } while (0)
#define PG8_MMA(ai, bj, At, Bt) do { __builtin_amdgcn_s_setprio(1); _Pragma("unroll") for (int m = 0; m < 4; ++m) _Pragma("unroll") for (int n = 0; n < 2; ++n) _Pragma("unroll") for (int k = 0; k < 2; ++k) \
        acc[ai][bj][m][n] = __builtin_amdgcn_mfma_f32_16x16x32_bf16(Bt[n][k], At[m][k], acc[ai][bj][m][n], 0, 0, 0); __builtin_amdgcn_s_setprio(0); } while (0)
#define PG8_WAIT_V(n) asm volatile("s_waitcnt vmcnt(" #n ")" ::: "memory")
#define PG8_WAIT_L(n) asm volatile("s_waitcnt lgkmcnt(" #n ")" ::: "memory")
#define PG8_BAR __builtin_amdgcn_s_barrier()
#define PG8_SCHED __builtin_amdgcn_sched_barrier(0)
    Unit cur, nxt; int ui = 0;
    if (!S.next(0, cur)) return;
    f32x4 acc[2][2][4][2];
#pragma unroll
    for (int a = 0; a < 2; ++a)
#pragma unroll
        for (int b = 0; b < 2; ++b)
#pragma unroll
            for (int m = 0; m < 4; ++m)
#pragma unroll
                for (int n = 0; n < 2; ++n) acc[a][b][m][n] = (f32x4){0.f, 0.f, 0.f, 0.f};
    bf16x8 At[4][2], B0[2][2], B1[2][2];
    const char* cA = (const char*)g.A + (size_t)cur.pm * tstep; const char* cB = (const char*)g.Bt + (size_t)cur.pn * tstep;
    if constexpr (SP2) {
        PG8_STAGE(PG8_SB(0, 0), cB); PG8_STAGE(PG8_SB(0, 1), cB + hstep); PG8_STAGE(PG8_SA(0, 0), cA); PG8_STAGE(PG8_SA(0, 1), cA + hstep);
        if (wr == 1) PG8_BAR;
        PG8_WAIT_V(2); PG8_BAR;
        PG8_STAGE(PG8_SB(1, 0), cB + kstep); PG8_STAGE(PG8_SA(1, 0), cA + kstep); PG8_STAGE(PG8_SB(1, 1), cB + hstep + kstep);
        PG8_WAIT_V(6); PG8_BAR;
    } else {
        PG8_STAGE(PG8_SB(0, 0), cB); PG8_STAGE(PG8_SA(0, 0), cA); PG8_STAGE(PG8_SB(0, 1), cB + hstep); PG8_STAGE(PG8_SA(0, 1), cA + hstep);
        if (wr == 1) PG8_BAR;
        PG8_WAIT_V(4); PG8_BAR;
        PG8_STAGE(PG8_SB(1, 0), cB + kstep); PG8_STAGE(PG8_SA(1, 0), cA + kstep); PG8_STAGE(PG8_SB(1, 1), cB + hstep + kstep);
        PG8_WAIT_V(6); PG8_BAR;
    }
    for (;;) {
        const bool has_next = S.next(ui + 1, nxt);
        const char* nA = has_next ? (const char*)g.A + (size_t)nxt.pm * tstep : cA; const char* nB = has_next ? (const char*)g.Bt + (size_t)nxt.pn * tstep : cB;
        for (int t = 0; t < nt; t += 2) {
            const bool last = (t == nt - 2);
            const char* a1 = cA + (size_t)(t + 1) * kstep;
            const char* a2 = last ? nA : cA + (size_t)(t + 2) * kstep; const char* b2 = last ? nB : cB + (size_t)(t + 2) * kstep;
            const char* a3 = a2 + kstep; const char* b3 = b2 + kstep;
            if constexpr (SP2) {
            PG8_LDB(B0, 0, 0); PG8_LDB(B1, 0, 1); PG8_SCHED; PG8_LDA(At, 0, 0); PG8_STAGE(PG8_SA(1, 1), a1 + hstep);
            PG8_WAIT_V(8); PG8_WAIT_L(0); PG8_BAR; PG8_MMA(0, 0, At, B0); PG8_MMA(0, 1, At, B1); PG8_BAR; PG8_SCHED;
            PG8_LDA(At, 0, 1); PG8_STAGE(PG8_SB(0, 0), b2); PG8_STAGE(PG8_SB(0, 1), b2 + hstep); PG8_STAGE(PG8_SA(0, 0), a2);
            PG8_WAIT_V(8); PG8_WAIT_L(0); PG8_BAR; PG8_MMA(1, 0, At, B0); PG8_MMA(1, 1, At, B1); PG8_BAR; PG8_SCHED;
            PG8_LDB(B0, 1, 0); PG8_LDB(B1, 1, 1); PG8_SCHED; PG8_LDA(At, 1, 0); PG8_STAGE(PG8_SA(0, 1), a2 + hstep);
            PG8_WAIT_V(8); PG8_WAIT_L(0); PG8_BAR; PG8_MMA(0, 0, At, B0); PG8_MMA(0, 1, At, B1); PG8_BAR; PG8_SCHED;
            PG8_LDA(At, 1, 1); PG8_STAGE(PG8_SB(1, 0), b3); PG8_STAGE(PG8_SB(1, 1), b3 + hstep); PG8_STAGE(PG8_SA(1, 0), a3);
            PG8_WAIT_V(8); PG8_WAIT_L(0); PG8_BAR; PG8_MMA(1, 0, At, B0); PG8_MMA(1, 1, At, B1); PG8_BAR; PG8_SCHED;
            } else {
            PG8_LDB(B0, 0, 0); PG8_SCHED; PG8_LDA(At, 0, 0); PG8_STAGE(PG8_SA(1, 1), a1 + hstep);
            PG8_WAIT_L(8); PG8_BAR; PG8_WAIT_L(0); PG8_MMA(0, 0, At, B0); PG8_BAR; PG8_SCHED;
            PG8_LDB(B1, 0, 1); PG8_STAGE(PG8_SB(0, 0), b2);
            PG8_BAR; PG8_WAIT_L(0); PG8_MMA(0, 1, At, B1); PG8_BAR;
            PG8_LDA(At, 0, 1); PG8_STAGE(PG8_SA(0, 0), a2);
            PG8_BAR; PG8_WAIT_L(0); PG8_MMA(1, 0, At, B0); PG8_BAR; PG8_SCHED;
            PG8_STAGE(PG8_SB(0, 1), b2 + hstep);
            PG8_WAIT_V(6); PG8_BAR; PG8_MMA(1, 1, At, B1); PG8_BAR;
            PG8_LDB(B0, 1, 0); PG8_SCHED; PG8_LDA(At, 1, 0); PG8_STAGE(PG8_SA(0, 1), a2 + hstep);
            PG8_WAIT_L(8); PG8_BAR; PG8_WAIT_L(0); PG8_MMA(0, 0, At, B0); PG8_BAR; PG8_SCHED;
            PG8_LDB(B1, 1, 1); PG8_STAGE(PG8_SB(1, 0), b3);
            PG8_BAR; PG8_WAIT_L(0); PG8_MMA(0, 1, At, B1); PG8_BAR;
            PG8_LDA(At, 1, 1); PG8_STAGE(PG8_SA(1, 0), a3);
            PG8_BAR; PG8_WAIT_L(0); PG8_MMA(1, 0, At, B0); PG8_BAR; PG8_SCHED;
            PG8_STAGE(PG8_SB(1, 1), b3 + hstep);
            PG8_WAIT_V(6); PG8_BAR; PG8_MMA(1, 1, At, B1); PG8_BAR;
            }
        }
        if constexpr (ALIGN_EPI) { if (wr == 0) PG8_BAR; }
        E(acc, cur, wr, wc, fr, fq);
        if (!has_next) break;
#pragma unroll
        for (int a = 0; a < 2; ++a)
#pragma unroll
            for (int b = 0; b < 2; ++b)
#pragma unroll
                for (int m = 0; m < 4; ++m)
#pragma unroll
                    for (int n = 0; n < 2; ++n) acc[a][b][m][n] = (f32x4){0.f, 0.f, 0.f, 0.f};
        cur = nxt; cA = nA; cB = nB; ++ui;
        if constexpr (ALIGN_EPI) { if (wr == 1) PG8_BAR; }
    }
    PG8_WAIT_V(0);
    if constexpr (!ALIGN_EPI) { if (wr == 0) PG8_BAR; }
    PG8_BAR;
#undef PG8_SA
#undef PG8_SB
#undef PG8_STAGE
#undef PG8_LDA
#undef PG8_LDB
#undef PG8_MMA
#undef PG8_WAIT_V
#undef PG8_WAIT_L
#undef PG8_BAR
#undef PG8_SCHED
}
}

__host__ __device__ __forceinline__ int pair_row(int ch, int w) { return 256 * (ch >> 7) + 128 * ((ch >> 2) & 1) + 32 * ((ch >> 5) & 3) + 16 * w + 4 * ((ch >> 3) & 3) + (ch & 3); }
__host__ __device__ __forceinline__ int plain8_row(int c) { return (c & ~255) + 128 * ((c >> 7) & 1) + 32 * ((c >> 5) & 3) + 16 * ((c >> 2) & 1) + 4 * ((c >> 3) & 3) + (c & 3); }
__device__ __forceinline__ int win_row(int n) {
    if (n < 1024) return pair_row(n, 0);
    if (n < 2048) return 2048 + pair_row(n - 1024, 0);
    if (n < 3072) return pair_row(n - 2048, 1);
    if (n < 3584) return 4096 + plain8_row(n - 3072);
    if (n < 4608) return 2048 + pair_row(n - 3584, 1);
    return 4608 + plain8_row(n - 4608);
}

struct EpiSwiGLU {
    bf16_t* H; int ldh;
    __device__ __forceinline__ void operator()(const f32x4 (&acc)[2][2][4][2], const pg8::Unit& u, int wr, int wc, int fr, int fq) const {
        const int row0 = u.pm * 256 + wr * 64 + fr, col0 = u.pn * 128 + wc * 32 + 8 * fq;
#pragma unroll
        for (int ai = 0; ai < 2; ++ai)
#pragma unroll
            for (int m = 0; m < 4; ++m) {
                bf16_t* rowp = H + (size_t)(row0 + ai * 128 + m * 16) * ldh + col0;
                float h[8];
#pragma unroll
                for (int bj = 0; bj < 2; ++bj)
#pragma unroll
                    for (int j = 0; j < 4; ++j) { const float g = acc[ai][bj][m][0][j], v = acc[ai][bj][m][1][j]; h[bj * 4 + j] = g * sigmoidf_(g) * v; }
                u32x4 w; w.x = cvt_pk_bf16(h[0], h[1]); w.y = cvt_pk_bf16(h[2], h[3]); w.z = cvt_pk_bf16(h[4], h[5]); w.w = cvt_pk_bf16(h[6], h[7]);
                *(u32x4*)rowp = w;
            }
    }
};
struct EpiZ {
    bf16_t* Z; const float* pool_scale;
    __device__ __forceinline__ void operator()(const f32x4 (&acc)[2][2][4][2], const pg8::Unit& u, int wr, int wc, int fr, int fq) const {
        const int row0 = u.pm * 256 + wr * 64 + fr;
        if (u.pn < 16) {
            const bool isu = u.pn < 8;
            const int col0 = (isu ? 128 * u.pn : 1024 + 128 * (u.pn - 8)) + wc * 32 + 8 * fq;
#pragma unroll
            for (int ai = 0; ai < 2; ++ai)
#pragma unroll
                for (int m = 0; m < 4; ++m) {
                    bf16_t* rowp = Z + (size_t)(row0 + ai * 128 + m * 16) * ZLD + col0;
                    float h[8];
#pragma unroll
                    for (int bj = 0; bj < 2; ++bj)
#pragma unroll
                        for (int j = 0; j < 4; ++j) { const float a = acc[ai][bj][m][0][j], b = acc[ai][bj][m][1][j]; h[bj * 4 + j] = isu ? a * b : a * sigmoidf_(b); }
                    u32x4 w; w.x = cvt_pk_bf16(h[0], h[1]); w.y = cvt_pk_bf16(h[2], h[3]); w.z = cvt_pk_bf16(h[4], h[5]); w.w = cvt_pk_bf16(h[6], h[7]);
                    *(u32x4*)rowp = w;
                }
        } else {
            const bool isp = u.pn < 18;
            const int cb = (isp ? 256 * (u.pn - 16) : 256 * (u.pn - 18)) + wc * 32 + 8 * fq;
            const int col0 = (isp ? 2048 : 2560) + cb;
            f32x4 ps[2][2];
#pragma unroll
            for (int bj = 0; bj < 2; ++bj)
#pragma unroll
                for (int n = 0; n < 2; ++n) ps[bj][n] = isp ? (f32x4){1.f, 1.f, 1.f, 1.f} : *(const f32x4*)(pool_scale + cb + 128 * bj + 4 * n);
#pragma unroll
            for (int ai = 0; ai < 2; ++ai)
#pragma unroll
                for (int m = 0; m < 4; ++m) {
                    bf16_t* rowp = Z + (size_t)(row0 + ai * 128 + m * 16) * ZLD + col0;
#pragma unroll
                    for (int bj = 0; bj < 2; ++bj) {
                        float h[8];
#pragma unroll
                        for (int n = 0; n < 2; ++n)
#pragma unroll
                            for (int j = 0; j < 4; ++j) { const float a = acc[ai][bj][m][n][j]; h[n * 4 + j] = isp ? a : sigmoidf_(a) * ps[bj][n][j]; }
                        u32x4 w; w.x = cvt_pk_bf16(h[0], h[1]); w.y = cvt_pk_bf16(h[2], h[3]); w.z = cvt_pk_bf16(h[4], h[5]); w.w = cvt_pk_bf16(h[6], h[7]);
                        *(u32x4*)(rowp + 128 * bj) = w;
                    }
                }
        }
    }
};
struct EpiRes {
    const float* base_p; const float* base_s; float* out; float scale;
    __device__ __forceinline__ void operator()(const f32x4 (&acc)[2][2][4][2], const pg8::Unit& u, int wr, int wc, int fr, int fq) const {
        const int row0 = u.pm * 256 + wr * 64 + fr, col0 = u.pn * 256 + wc * 32 + 4 * fq;
#pragma unroll
        for (int ai = 0; ai < 2; ++ai)
#pragma unroll
            for (int m = 0; m < 4; ++m) {
                const int row = row0 + ai * 128 + m * 16;
                if (row < MT) {
                    const float* bp = (row < MPR ? base_p + (size_t)row * D : base_s + (size_t)(row - MPR) * D) + col0;
                    float* op = out + (size_t)row * D + col0;
#pragma unroll
                    for (int bj = 0; bj < 2; ++bj)
#pragma unroll
                        for (int n = 0; n < 2; ++n) { const f32x4 b = *(const f32x4*)(bp + bj * 128 + n * 16); *(f32x4*)(op + bj * 128 + n * 16) = b * ALPHA + acc[ai][bj][m][n] * scale; }
                }
            }
    }
};


#define XB_TMO      128
#define XB_XCNT(j)  (256  + 64 * (j))
#define XB_XSUB(j)  (1280 + 64 * (j))
#define XB_XGEN(j)  (2304 + 64 * (j))
#define XB_TOP      3328
#define XB_TOPGEN   3392
#define XCD_BAR_WORDS 3456
#define XB_SPIN_CAP (1u << 20)
__device__ __forceinline__ unsigned xb_ld(unsigned* p)              { return __hip_atomic_load(p, __ATOMIC_RELAXED, __HIP_MEMORY_SCOPE_AGENT); }
__device__ __forceinline__ unsigned xb_add(unsigned* p, unsigned v) { return __hip_atomic_fetch_add(p, v, __ATOMIC_RELAXED, __HIP_MEMORY_SCOPE_AGENT); }
__device__ __forceinline__ unsigned xb_xcc_id() { return (unsigned)__builtin_amdgcn_s_getreg((3 << 11) | 20) & 0xFu; }
#define XB_SPIN(cond, bar) do { unsigned _sp = 0; while (cond) { __builtin_amdgcn_s_sleep(1); \
    if ((++_sp & 255u) == 0u) { if (xb_ld(&(bar)[XB_TMO])) break; if (_sp > XB_SPIN_CAP) { atomicAdd(&(bar)[XB_TMO], 1u); break; } } } } while (0)
struct XcdBarrier { unsigned* bar; unsigned x; volatile LAS unsigned* st; };
__device__ __forceinline__ XcdBarrier xcd_barrier_post(unsigned* bar, volatile LAS unsigned* st) {
    XcdBarrier b; b.bar = bar; b.x = xb_xcc_id(); b.st = st;
    if (threadIdx.x == 0) (void)xb_add(&bar[XB_XCNT(b.x)], 1u);
    return b;
}
__device__ __forceinline__ void xcd_barrier_complete(unsigned* bar, unsigned x, unsigned& nloc, unsigned& nx) {
    const unsigned G = gridDim.x * gridDim.y * gridDim.z;
    unsigned sum, cnt, mine, sp = 0u;
    for (;;) {
        sum = 0u; cnt = 0u; mine = 0u;
#pragma unroll
        for (unsigned j = 0; j < 16; ++j) { const unsigned c = xb_ld(&bar[XB_XCNT(j)]); sum += c; cnt += (c > 0u) ? 1u : 0u; mine = (j == x) ? c : mine; }
        if (sum == G) break;
        __builtin_amdgcn_s_sleep(1);
        if ((++sp & 255u) == 0u) { if (xb_ld(&bar[XB_TMO])) break; if (sp > XB_SPIN_CAP) { atomicAdd(&bar[XB_TMO], 1u); break; } }
    }
    nloc = mine > 0u ? mine : 1u; nx = cnt > 0u ? cnt : 1u;
}
__device__ __forceinline__ void xcd_barrier(const XcdBarrier& b) {
    asm volatile("s_waitcnt vmcnt(0)" ::: "memory");
    __syncthreads();
    if (threadIdx.x == 0) {
        unsigned* bar = b.bar;
        __builtin_amdgcn_s_waitcnt(0);
        unsigned nloc = b.st[0], nx = b.st[1];
        if (nloc == 0u) { xcd_barrier_complete(bar, b.x, nloc, nx); b.st[0] = nloc; b.st[1] = nx; }
        const unsigned old = xb_add(&bar[XB_XSUB(b.x)], 1u);
        const unsigned gen = old / nloc;
        if (old + 1u == (gen + 1u) * nloc) {
            __builtin_amdgcn_fence(__ATOMIC_RELEASE, "agent");
            asm volatile("s_waitcnt vmcnt(0)" ::: "memory");
            const unsigned og = xb_add(&bar[XB_TOP], 1u);
            const unsigned tg = og / nx;
            if (og + 1u == (tg + 1u) * nx) xb_add(&bar[XB_TOPGEN], 1u);
            else XB_SPIN(xb_ld(&bar[XB_TOPGEN]) == tg, bar);
            __builtin_amdgcn_fence(__ATOMIC_ACQUIRE, "agent");
            xb_add(&bar[XB_XGEN(b.x)], 1u);
            asm volatile("s_waitcnt vmcnt(0)" ::: "memory");
        } else {
            XB_SPIN(xb_ld(&bar[XB_XGEN(b.x)]) == gen, bar);
            __builtin_amdgcn_fence(__ATOMIC_ACQUIRE, "agent");
            asm volatile("s_waitcnt vmcnt(0)" ::: "memory");
        }
    }
    __syncthreads();
}

struct Args { const float* in[21]; float* out; unsigned char* ws; int ph_lo, ph_hi; };
enum { I_XP = 0, I_XS, I_SC, I_SP, I_LN1G, I_LN1B, I_WG1, I_WU1, I_WD1, I_WIN, I_CW, I_PW, I_PS, I_WOUT, I_LN2G, I_LN2B, I_WG2, I_WU2, I_WD2, I_LN3G, I_LN3B };

__device__ __forceinline__ float wave_sum(float v) {
#pragma unroll
    for (int o = 1; o < 64; o <<= 1) v += __shfl_xor(v, o);
    return v;
}
__device__ __forceinline__ void transpose_item(const float* W, int K, int N, bf16_t* WT, LAS float* scr, int item, int lane, int mode) {
    const int nblk = N / 32, kb = item / nblk, nb = item % nblk, k0 = 64 * kb, n0 = 32 * nb;
#pragma unroll 8
    for (int i = 0; i < 32; ++i) { const int kk = 2 * i + (lane >> 5); scr[kk * 33 + (lane & 31)] = W[(size_t)(k0 + kk) * N + n0 + (lane & 31)]; }
    LDS_WAIT(); asm volatile("" ::: "memory");
    const int c = lane & 7;
#pragma unroll
    for (int j = 0; j < 4; ++j) { const int n = (lane >> 3) + 8 * j; const LAS float* s = scr + (8 * c) * 33 + n;
        const int nn = n0 + n; const int r = mode == 0 ? nn : mode == 1 ? pair_row(nn, 0) : mode == 2 ? pair_row(nn, 1) : win_row(nn);
        u32x4 o; o.x = cvt_pk_bf16(s[0 * 33], s[1 * 33]); o.y = cvt_pk_bf16(s[2 * 33], s[3 * 33]); o.z = cvt_pk_bf16(s[4 * 33], s[5 * 33]); o.w = cvt_pk_bf16(s[6 * 33], s[7 * 33]);
        *(u32x4*)(WT + (size_t)r * K + k0 + 8 * c) = o; }
    LDS_WAIT(); asm volatile("" ::: "memory");
}

__device__ __forceinline__ void phase_prologue(const Args& a, LAS unsigned char* lds, int vcu, int G, int wave, int lane) {
    unsigned char* ws = a.ws;
    LAS float* scr = (LAS float*)(lds + wave * 16384);
    const int gw = vcu * 8 + wave, NGW = G * 8;
    constexpr int I_GU = (D / 64) * (FF / 32), I_DN = (FF / 64) * (D / 32), I_IN = (D / 64) * (NIN / 32), I_O = (D / 64) * (D / 32), I_P = (128 / 64) * (256 / 32);
    constexpr int NITEMS = 4 * I_GU + 2 * I_DN + I_IN + I_O + 4 * I_P;
    for (int it = gw; it < NITEMS; it += NGW) {
        int r = it;
        if (r < I_GU) { transpose_item(a.in[I_WG1], D, FF, (bf16_t*)(ws + WS_WGU1), scr, r, lane, 1); continue; } r -= I_GU;
        if (r < I_GU) { transpose_item(a.in[I_WU1], D, FF, (bf16_t*)(ws + WS_WGU1), scr, r, lane, 2); continue; } r -= I_GU;
        if (r < I_DN) { transpose_item(a.in[I_WD1], FF, D, (bf16_t*)(ws + WS_WD1), scr, r, lane, 0); continue; } r -= I_DN;
        if (r < I_IN) { transpose_item(a.in[I_WIN], D, NIN, (bf16_t*)(ws + WS_WIN), scr, r, lane, 3); continue; } r -= I_IN;
        if (r < I_O) { transpose_item(a.in[I_WOUT], D, D, (bf16_t*)(ws + WS_WOUT), scr, r, lane, 0); continue; } r -= I_O;
        if (r < I_GU) { transpose_item(a.in[I_WG2], D, FF, (bf16_t*)(ws + WS_WGU2), scr, r, lane, 1); continue; } r -= I_GU;
        if (r < I_GU) { transpose_item(a.in[I_WU2], D, FF, (bf16_t*)(ws + WS_WGU2), scr, r, lane, 2); continue; } r -= I_GU;
        if (r < I_DN) { transpose_item(a.in[I_WD2], FF, D, (bf16_t*)(ws + WS_WD2), scr, r, lane, 0); continue; } r -= I_DN;
        { const int g = r / I_P; transpose_item(a.in[I_PW] + (size_t)g * 128 * 256, 128, 256, (bf16_t*)(ws + WS_PW) + (size_t)g * 256 * 128, scr, r % I_P, lane, 0); }
    }
    const size_t gt = (size_t)vcu * 512 + threadIdx.x, NT = (size_t)G * 512;
    constexpr size_t NCH = (size_t)MT * D / 8, NCHP = (size_t)MPAD * D / 8, NPR = (size_t)MPR * D / 8;
    u32x4* ra = (u32x4*)(ws + WS_RA); u32x4* rc = (u32x4*)(ws + WS_RC);
    for (size_t c = gt; c < NCHP; c += NT) {
        if (c < NCH) {
            const float* src = c < NPR ? a.in[I_XP] + c * 8 : a.in[I_XS] + (c - NPR) * 8;
            const f32x4 v0 = *(const f32x4*)src, v1 = *(const f32x4*)(src + 4);
            u32x4 o; o.x = cvt_pk_bf16(v0[0], v0[1]); o.y = cvt_pk_bf16(v0[2], v0[3]); o.z = cvt_pk_bf16(v1[0], v1[1]); o.w = cvt_pk_bf16(v1[2], v1[3]);
            ra[c] = o;
        } else { ra[c] = (u32x4){0u, 0u, 0u, 0u}; rc[c] = (u32x4){0u, 0u, 0u, 0u}; }
    }
}

__device__ __forceinline__ void phase_ln(float* y, const float* gam, const float* bet, bf16_t* xb, int vcu, int G, int wave, int lane) {
    const int gw = vcu * 8 + wave, NGW = G * 8;
    f32x4 gv[4], bv[4];
#pragma unroll
    for (int j = 0; j < 4; ++j) { gv[j] = *(const f32x4*)(gam + 4 * lane + 256 * j); bv[j] = *(const f32x4*)(bet + 4 * lane + 256 * j); }
    for (int row = gw; row < MT; row += NGW) {
        f32x4* yr = (f32x4*)(y + (size_t)row * D) + lane;
        f32x4 v[4]; float s = 0.f;
#pragma unroll
        for (int j = 0; j < 4; ++j) { v[j] = yr[64 * j]; s += (v[j][0] + v[j][1]) + (v[j][2] + v[j][3]); }
        const float mean = wave_sum(s) * (1.f / D); float s2 = 0.f;
#pragma unroll
        for (int j = 0; j < 4; ++j) { v[j] = v[j] - mean; s2 += (v[j][0] * v[j][0] + v[j][1] * v[j][1]) + (v[j][2] * v[j][2] + v[j][3] * v[j][3]); }
        const float rstd = 1.f / sqrtf(wave_sum(s2) * (1.f / D) + LN_EPS);
#pragma unroll
        for (int j = 0; j < 4; ++j) { v[j] = v[j] * rstd * gv[j] + bv[j]; yr[64 * j] = v[j]; }
        if (xb) { u32x2* o8 = (u32x2*)(xb + (size_t)row * D) + lane;
#pragma unroll
            for (int j = 0; j < 4; ++j) { u32x2 w; w.x = cvt_pk_bf16(v[j][0], v[j][1]); w.y = cvt_pk_bf16(v[j][2], v[j][3]); o8[64 * j] = w; } }
    }
}

__device__ __forceinline__ void phase_mix(const Args& a, LAS unsigned char* lds, int vcu, int G, int wave, int lane) {
    const bf16_t* Z = (const bf16_t*)(a.ws + WS_RB); bf16_t* Mo = (bf16_t*)(a.ws + WS_RA); const bf16_t* PWT = (const bf16_t*)(a.ws + WS_PW);
    const float* sconv = a.in[I_SC]; const float* spool = a.in[I_SP]; const float* cw = a.in[I_CW];
    constexpr int PLD = 136;
    LAS bf16_t* Ps = (LAS bf16_t*)lds;
    LAS bf16_t* Qs = (LAS bf16_t*)(lds + 80 * PLD * 2);
    const int tid = threadIdx.x, fr = lane & 15, fq = lane >> 4;
    for (int item = vcu; item < (MT / 64) * 4; item += G) {
        const int rt = item >> 2, g = item & 3, r0 = rt * 64, w = 2 << g;
        const bool smp = r0 >= MPR; const int t0 = r0 & (SEQ - 1);
        for (int idx = tid; idx < 80 * 16; idx += 512) {
            const int i = idx >> 4, ck = idx & 15; u32x4 v = (u32x4){0u, 0u, 0u, 0u};
            const bool valid = smp ? (i >= 16) : (t0 - 16 + i >= 0);
            if (valid) v = *(const u32x4*)(Z + (size_t)(r0 - 16 + i) * ZLD + 2048 + 128 * g + 8 * ck);
            *(LAS u32x4*)(Ps + i * PLD + 8 * ck) = v;
        }
        __syncthreads();
        for (int idx = tid; idx < 64 * 16; idx += 512) {
            const int i = idx >> 4, ck = idx & 15;
            float s[8], pc[8];
            { const u32x4 v = *(const LAS u32x4*)(Ps + (16 + i) * PLD + 8 * ck);
              pc[0] = bf_lo(v.x); pc[1] = bf_hi(v.x); pc[2] = bf_lo(v.y); pc[3] = bf_hi(v.y); pc[4] = bf_lo(v.z); pc[5] = bf_hi(v.z); pc[6] = bf_lo(v.w); pc[7] = bf_hi(v.w); }
#pragma unroll
            for (int e = 0; e < 8; ++e) s[e] = pc[e];
            float inv;
            if (!smp) {
                for (int j = 1; j < w; ++j) { const u32x4 v = *(const LAS u32x4*)(Ps + (16 + i - j) * PLD + 8 * ck);
                    s[0] += bf_lo(v.x); s[1] += bf_hi(v.x); s[2] += bf_lo(v.y); s[3] += bf_hi(v.y); s[4] += bf_lo(v.z); s[5] += bf_hi(v.z); s[6] += bf_lo(v.w); s[7] += bf_hi(v.w); }
                const int cnt = (t0 + i + 1) < w ? (t0 + i + 1) : w; inv = 1.0f / (float)cnt;
            } else {
                const float* sp = spool + (size_t)(r0 - MPR + i) * 15 * DP + 128 * g + 8 * ck;
                for (int j = 1; j < w; ++j) { const f32x4 v0 = *(const f32x4*)(sp + (size_t)(15 - j) * DP), v1 = *(const f32x4*)(sp + (size_t)(15 - j) * DP + 4);
                    s[0] += v0[0]; s[1] += v0[1]; s[2] += v0[2]; s[3] += v0[3]; s[4] += v1[0]; s[5] += v1[1]; s[6] += v1[2]; s[7] += v1[3]; }
                inv = 1.0f / (float)w;
            }
#pragma unroll
            for (int e = 0; e < 8; ++e) s[e] = s[e] * inv - pc[e];
            u32x4 o; o.x = cvt_pk_bf16(s[0], s[1]); o.y = cvt_pk_bf16(s[2], s[3]); o.z = cvt_pk_bf16(s[4], s[5]); o.w = cvt_pk_bf16(s[6], s[7]);
            *(LAS u32x4*)(Qs + i * PLD + 8 * ck) = o;
        }
        __syncthreads();
        f32x4 acc[4][2];
#pragma unroll
        for (int mt = 0; mt < 4; ++mt)
#pragma unroll
            for (int nt = 0; nt < 2; ++nt) acc[mt][nt] = (f32x4){0.f, 0.f, 0.f, 0.f};
        const bf16_t* wbase = PWT + (size_t)g * 256 * 128 + (size_t)(wave * 32 + fr) * 128 + fq * 8;
#pragma unroll
        for (int ks = 0; ks < 4; ++ks) {
            bf16x8 wf[2], qf[4];
#pragma unroll
            for (int nt = 0; nt < 2; ++nt) wf[nt] = *(const bf16x8*)(wbase + (size_t)nt * 16 * 128 + ks * 32);
#pragma unroll
            for (int mt = 0; mt < 4; ++mt) qf[mt] = *(const LAS bf16x8*)(Qs + (mt * 16 + fr) * PLD + ks * 32 + fq * 8);
#pragma unroll
            for (int mt = 0; mt < 4; ++mt)
#pragma unroll
                for (int nt = 0; nt < 2; ++nt) acc[mt][nt] = __builtin_amdgcn_mfma_f32_16x16x32_bf16(wf[nt], qf[mt], acc[mt][nt], 0, 0, 0);
        }
#pragma unroll
        for (int nt = 0; nt < 2; ++nt) {
            const int e = 256 * g + wave * 32 + nt * 16 + 4 * fq;
            const f32x4 c0 = *(const f32x4*)(cw + e), c1 = *(const f32x4*)(cw + D + e), c2 = *(const f32x4*)(cw + 2 * D + e);
#pragma unroll
            for (int mt = 0; mt < 4; ++mt) {
                const int row = r0 + mt * 16 + fr; const bf16_t* zr = Z + (size_t)row * ZLD;
                const u32x2 uc = *(const u32x2*)(zr + e), bg = *(const u32x2*)(zr + 1024 + e), sg = *(const u32x2*)(zr + 2560 + e);
                f32x4 u0 = (f32x4){bf_lo(uc.x), bf_hi(uc.x), bf_lo(uc.y), bf_hi(uc.y)}, u1, u2;
                if (smp) { const float* sc = sconv + (size_t)(row - MPR) * 2 * D + e; u2 = *(const f32x4*)sc; u1 = *(const f32x4*)(sc + D); }
                else {
                    const int t = row & (SEQ - 1);
                    u1 = (f32x4){0.f, 0.f, 0.f, 0.f}; u2 = u1;
                    if (t >= 1) { const u32x2 x = *(const u32x2*)(zr - ZLD + e); u1 = (f32x4){bf_lo(x.x), bf_hi(x.x), bf_lo(x.y), bf_hi(x.y)}; }
                    if (t >= 2) { const u32x2 x = *(const u32x2*)(zr - 2 * ZLD + e); u2 = (f32x4){bf_lo(x.x), bf_hi(x.x), bf_lo(x.y), bf_hi(x.y)}; }
                }
                const f32x4 conv = c0 * u2 + c1 * u1 + c2 * u0;
                const f32x4 bgf = (f32x4){bf_lo(bg.x), bf_hi(bg.x), bf_lo(bg.y), bf_hi(bg.y)}, sgf = (f32x4){bf_lo(sg.x), bf_hi(sg.x), bf_lo(sg.y), bf_hi(sg.y)};
                const f32x4 mv = bgf * conv + sgf * acc[mt][nt];
                u32x2 o; o.x = cvt_pk_bf16(mv[0], mv[1]); o.y = cvt_pk_bf16(mv[2], mv[3]);
                *(u32x2*)(Mo + (size_t)row * D + e) = o;
            }
        }
        __syncthreads();
    }
    float* out = a.out;
    const size_t gt = (size_t)vcu * 512 + tid, NT = (size_t)G * 512;
    for (size_t i = gt; i < OUT_END - OUT_CONVP; i += NT) {
        const size_t o = OUT_CONVP + i; float v;
        if (o < OUT_POOLP) { const int b = (int)(i / (2 * D)), k = (int)(i / D) & 1, ch = (int)(i % D); v = __uint_as_float((unsigned)Z[(size_t)(b * SEQ + SEQ - 2 + k) * ZLD + ch] << 16); }
        else if (o < OUT_CONVS) { const size_t q = o - OUT_POOLP; const int b = (int)(q / (15 * DP)), r = (int)(q / DP) % 15, c = (int)(q % DP); v = __uint_as_float((unsigned)Z[(size_t)(b * SEQ + SEQ - 15 + r) * ZLD + 2048 + c] << 16); }
        else if (o < OUT_POOLS) { const size_t q = o - OUT_CONVS; const int b = (int)(q / (2 * D)), k = (int)(q / D) & 1, ch = (int)(q % D);
            v = k == 0 ? sconv[(size_t)b * 2 * D + D + ch] : __uint_as_float((unsigned)Z[(size_t)(MPR + b) * ZLD + ch] << 16); }
        else { const size_t q = o - OUT_POOLS; const int b = (int)(q / (15 * DP)), r = (int)(q / DP) % 15, c = (int)(q % DP);
            v = r < 14 ? spool[(size_t)b * 15 * DP + (size_t)(r + 1) * DP + c] : __uint_as_float((unsigned)Z[(size_t)(MPR + b) * ZLD + 2048 + c] << 16); }
        out[o] = v;
    }
}

__global__ void __launch_bounds__(512, 2) fwd_kernel(Args args) {
    extern __shared__ __attribute__((aligned(16))) unsigned char lds_raw[];
    LAS unsigned char* lds = (LAS unsigned char*)lds_raw;
    const int tid = threadIdx.x, lane = tid & 63, wave = __builtin_amdgcn_readfirstlane(tid >> 6);
    const int G = gridDim.x; const int bx = blockIdx.x; const int vcu = (G % 8 == 0) ? (bx % 8) * (G / 8) + bx / 8 : bx;
    const int lo = args.ph_lo, hi = args.ph_hi;
    unsigned char* ws = args.ws;
#define IN(k) (lo <= (k) && (k) < hi)
    volatile LAS unsigned* misc = (volatile LAS unsigned*)(lds + 131072 + 512);
    if (tid < 64) misc[tid] = 0u;
    __syncthreads();
    XcdBarrier bar = xcd_barrier_post((unsigned*)(ws + WS_CTL) + 4096, misc + 8);
#define SEAM(k) do { if (IN(k) && IN((k) + 1)) { if ((k) == CG_SEAM) cg::this_grid().sync(); else xcd_barrier(bar); } } while (0)
    if (IN(0)) { phase_prologue(args, lds, vcu, G, wave, lane); }
    SEAM(0);
    if (IN(1)) { pg8::Gemm g{(const bf16_t*)(ws + WS_RA), (const bf16_t*)(ws + WS_WGU1), MPAD, NGU, D}; pg8::StaticOrder S; S.init(MPAD, NGU, G, bx);
        EpiSwiGLU E{(bf16_t*)(ws + WS_RB), FF}; pg8::gemm_phase<EpiSwiGLU, true, true>(lds, g, S, E); }
    SEAM(1);
    if (IN(2)) { pg8::Gemm g{(const bf16_t*)(ws + WS_RB), (const bf16_t*)(ws + WS_WD1), MPAD, D, FF}; pg8::StaticOrder S; S.init(MPAD, D, G, bx);
        EpiRes E{args.in[I_XP], args.in[I_XS], args.out, 0.5f}; pg8::gemm_phase<EpiRes, true, true>(lds, g, S, E); }
    SEAM(2);
    if (IN(3)) { phase_ln(args.out, args.in[I_LN1G], args.in[I_LN1B], (bf16_t*)(ws + WS_RC), vcu, G, wave, lane); }
    SEAM(3);
    if (IN(4)) { pg8::Gemm g{(const bf16_t*)(ws + WS_RC), (const bf16_t*)(ws + WS_WIN), MPAD, NIN, D}; pg8::StaticOrder S; S.init(MPAD, NIN, G, bx);
        EpiZ E{(bf16_t*)(ws + WS_RB), args.in[I_PS]}; pg8::gemm_phase<EpiZ, true, true>(lds, g, S, E); }
    SEAM(4);
    if (IN(5)) { phase_mix(args, lds, vcu, G, wave, lane); }
    SEAM(5);
    if (IN(6)) { pg8::Gemm g{(const bf16_t*)(ws + WS_RA), (const bf16_t*)(ws + WS_WOUT), MPAD, D, D}; pg8::StaticOrder S; S.init(MPAD, D, G, bx);
        EpiRes E{args.out, args.out + (size_t)MPR * D, args.out, 1.0f}; pg8::gemm_phase<EpiRes, true, true>(lds, g, S, E); }
    SEAM(6);
    if (IN(7)) { phase_ln(args.out, args.in[I_LN2G], args.in[I_LN2B], (bf16_t*)(ws + WS_RC), vcu, G, wave, lane); }
    SEAM(7);
    if (IN(8)) { pg8::Gemm g{(const bf16_t*)(ws + WS_RC), (const bf16_t*)(ws + WS_WGU2), MPAD, NGU, D}; pg8::StaticOrder S; S.init(MPAD, NGU, G, bx);
        EpiSwiGLU E{(bf16_t*)(ws + WS_RB), FF}; pg8::gemm_phase<EpiSwiGLU, true, true>(lds, g, S, E); }
    SEAM(8);
    if (IN(9)) { pg8::Gemm g{(const bf16_t*)(ws + WS_RB), (const bf16_t*)(ws + WS_WD2), MPAD, D, FF}; pg8::StaticOrder S; S.init(MPAD, D, G, bx);
        EpiRes E{args.out, args.out + (size_t)MPR * D, args.out, 0.5f}; pg8::gemm_phase<EpiRes, true, true>(lds, g, S, E); }
    SEAM(9);
    if (IN(10)) { phase_ln(args.out, args.in[I_LN3G], args.in[I_LN3B], nullptr, vcu, G, wave, lane); }
#undef IN
#undef SEAM
}

#ifndef N_LAUNCHES
#define N_LAUNCHES 1
#endif

extern "C" void kernel_launch(void* const* d_in, const int* in_sizes, int n_in, void* d_out, int out_size, void* d_ws, size_t ws_size, hipStream_t stream) {
    static int grid = 0;
    if (grid == 0) {
        if (n_in != 21 || in_sizes[0] != MPR * D || (size_t)out_size != OUT_END || ws_size < WS_END) {
            fprintf(stderr, "kernel_launch: unexpected shapes: n_in %d in0 %d out %d ws %zu\n", n_in, n_in > 0 ? in_sizes[0] : -1, out_size, ws_size); grid = -1; return; }
        int dev = 0, cus = 0, per_cu = 0;
        (void)hipGetDevice(&dev); (void)hipDeviceGetAttribute(&cus, hipDeviceAttributeMultiprocessorCount, dev);
        if (hipFuncSetAttribute((const void*)fwd_kernel, hipFuncAttributeMaxDynamicSharedMemorySize, LDS_BYTES) != hipSuccess) { fprintf(stderr, "kernel_launch: hipFuncSetAttribute failed\n"); grid = -1; return; }
        if (hipOccupancyMaxActiveBlocksPerMultiprocessor(&per_cu, (const void*)fwd_kernel, 512, LDS_BYTES) != hipSuccess || per_cu < 1) { fprintf(stderr, "kernel_launch: occupancy query says %d\n", per_cu); (void)hipGetLastError(); grid = -1; return; }
        grid = cus;
    }
    if (grid < 0) return;
    if (hipMemsetAsync((char*)d_ws + WS_CTL, 0, CTL_ZERO_BYTES, stream) != hipSuccess) { fprintf(stderr, "kernel_launch: memset failed\n"); return; }
    Args a{};
    for (int i = 0; i < 21; ++i) a.in[i] = (const float*)d_in[i];
    a.out = (float*)d_out; a.ws = (unsigned char*)d_ws;
    if (N_LAUNCHES == 1) {
        a.ph_lo = 0; a.ph_hi = NPHASE;
        void* params[] = {&a};
        hipError_t e = hipLaunchCooperativeKernel((const void*)fwd_kernel, dim3(grid), dim3(512), params, LDS_BYTES, stream);
        if (e != hipSuccess) fprintf(stderr, "cooperative launch failed: %s (grid %d)\n", hipGetErrorString(e), grid);
    } else {
        for (int p = 0; p < NPHASE; ++p) { a.ph_lo = p; a.ph_hi = p + 1; hipLaunchKernelGGL(fwd_kernel, dim3(grid), dim3(512), LDS_BYTES, stream, a); }
    }
}
```
